# Optimizing an MI355X kernel written in HIP

```python
import jax, jax.numpy as jnp
from jax import lax
import numpy as np

D_MODEL = 2048
BATCH = 4
SEQ = 4096
DEPTH = 1

CHUNK = 64
Q_BLOCK = 128
N_MEM = 256
EPS = 1e-6
MLA_HEADS = 16
Q_LORA_RANK = 512
KV_LORA_RANK = 512
QK_NOPE_DIM = 128
QK_ROPE_DIM = 64
V_HEAD_DIM = 128
ROPE_BASE = 10000.0
MLA_WIDTH = MLA_HEADS * V_HEAD_DIM
MLSTM_HEADS = 8
MLSTM_QK_DIM = 128
MLSTM_V_DIM = 256
MLSTM_CONV = 4
MLSTM_QK_WIDTH = MLSTM_HEADS * MLSTM_QK_DIM
MLSTM_V_WIDTH = MLSTM_HEADS * MLSTM_V_DIM
CROSS_HEADS = 4
CROSS_HEAD_DIM = 128
CROSS_WIDTH = CROSS_HEADS * CROSS_HEAD_DIM
D_FF = 5632
FFN_CONV = 3
IN_SPLITS = (Q_LORA_RANK, KV_LORA_RANK, QK_ROPE_DIM,
             MLSTM_QK_WIDTH, MLSTM_QK_WIDTH, MLSTM_V_WIDTH, MLSTM_HEADS, MLSTM_HEADS, MLSTM_V_WIDTH,
             D_MODEL, D_MODEL)
IN_WIDTH = (Q_LORA_RANK + KV_LORA_RANK + QK_ROPE_DIM + 2 * MLSTM_QK_WIDTH + MLSTM_V_WIDTH
            + 2 * MLSTM_HEADS + MLSTM_V_WIDTH + 2 * D_MODEL)

kernel_name = "hybrid_mla_mlstm_gated_streaming_layer"


def rms_norm(x, g):
    xf = x.astype(jnp.float32)
    y = xf * lax.rsqrt(jnp.mean(xf * xf, axis=-1, keepdims=True) + EPS)
    return (y * g.astype(jnp.float32)).astype(x.dtype)


def causal_dwconv(x, w):
    k_width, s = w.shape[0], x.shape[1]
    xp = jnp.pad(x, ((0, 0), (k_width - 1, 0), (0, 0)))
    return sum(xp[:, j:j + s] * w[j] for j in range(k_width))


def rope_tables(positions):
    inv_freq = ROPE_BASE ** (-jnp.arange(0, QK_ROPE_DIM, 2, dtype=jnp.float32) / QK_ROPE_DIM)
    ang = positions.astype(jnp.float32)[..., None] * inv_freq
    return jnp.cos(ang), jnp.sin(ang)


def apply_rope(x, cos, sin):
    half = x.shape[-1] // 2
    x1, x2 = x[..., :half], x[..., half:]
    return jnp.concatenate([x1 * cos - x2 * sin, x2 * cos + x1 * sin], axis=-1).astype(x.dtype)


def mla_attention(z_qa, z_kv, z_kpe, cos, sin, g_qa, w_qb, g_kva, w_kvb,
                  g_qn_nope, g_qn_pe, g_kn_nope, g_kn_pe):
    b, s, _ = z_qa.shape
    q = (rms_norm(z_qa, g_qa) @ w_qb).reshape(b, s, MLA_HEADS, QK_NOPE_DIM + QK_ROPE_DIM)
    kv = (rms_norm(z_kv, g_kva) @ w_kvb).reshape(b, s, MLA_HEADS, QK_NOPE_DIM + V_HEAD_DIM)
    q_nope = rms_norm(q[..., :QK_NOPE_DIM], g_qn_nope)
    q_pe = apply_rope(rms_norm(q[..., QK_NOPE_DIM:], g_qn_pe), cos[:, :, None], sin[:, :, None])
    k_nope = rms_norm(kv[..., :QK_NOPE_DIM], g_kn_nope)
    v = kv[..., QK_NOPE_DIM:]
    k_pe = apply_rope(rms_norm(z_kpe, g_kn_pe), cos, sin)
    scale = (QK_NOPE_DIM + QK_ROPE_DIM) ** -0.5
    outs = []
    for j in range(s // Q_BLOCK):
        q0, q1 = j * Q_BLOCK, (j + 1) * Q_BLOCK
        k_end = q1
        sc = (jnp.einsum('bqhd,bkhd->bhqk', q_nope[:, q0:q1], k_nope[:, :k_end])
              + jnp.einsum('bqhr,bkr->bhqk', q_pe[:, q0:q1], k_pe[:, :k_end])).astype(jnp.float32) * scale
        q_chunk = (q0 + jnp.arange(Q_BLOCK)) // CHUNK
        k_chunk = jnp.arange(k_end) // CHUNK
        sc = jnp.where(k_chunk[None, :] <= q_chunk[:, None], sc, -jnp.inf)
        p = jax.nn.softmax(sc, axis=-1).astype(v.dtype)
        outs.append(jnp.einsum('bhqk,bkhd->bqhd', p, v[:, :k_end]))
    return jnp.concatenate(outs, axis=1).reshape(b, s, MLA_WIDTH)


def mlstm(zq, zk, zv, zi, zf, zo, conv_qk, b_if, g_hnorm):
    b, s, _ = zq.shape
    h_, dk, dv, l_ = MLSTM_HEADS, MLSTM_QK_DIM, MLSTM_V_DIM, CHUNK
    nc = s // l_
    qk = jax.nn.silu(causal_dwconv(jnp.concatenate([zq, zk], axis=-1), conv_qk))

    def to_chunks(t, d):
        return t.astype(jnp.float32).reshape(b, nc, l_, h_, d).transpose(1, 0, 3, 2, 4)

    q = to_chunks(qk[..., :MLSTM_QK_WIDTH], dk) * (dk ** -0.5)
    k = to_chunks(qk[..., MLSTM_QK_WIDTH:], dk)
    v = to_chunks(zv, dv)
    gates = (jnp.concatenate([zi, zf], axis=-1) + b_if).astype(jnp.float32)

    def gate_chunks(t):
        return t.reshape(b, nc, l_, h_).transpose(1, 0, 3, 2)

    log_i = gate_chunks(gates[..., :h_])
    bcum = jnp.cumsum(gate_chunks(jax.nn.log_sigmoid(gates[..., h_:])), axis=-1)
    causal = jnp.tril(jnp.ones((l_, l_), dtype=bool))

    def step(carry, inp):
        c_mat, n_vec, m = carry
        qc, kc, vc, bc, ic = inp
        logw = jnp.where(causal, bc[..., :, None] - bc[..., None, :] + ic[..., None, :], -jnp.inf)
        inter = bc + m[..., None]
        m_t = jnp.maximum(inter, jnp.max(logw, axis=-1))
        w_intra = jnp.exp(logw - m_t[..., None])
        w_inter = jnp.exp(inter - m_t)
        sc = jnp.einsum('bhtd,bhsd->bhts', qc, kc) * w_intra
        num = w_inter[..., None] * jnp.einsum('bhtd,bhde->bhte', qc, c_mat) + jnp.einsum('bhts,bhse->bhte', sc, vc)
        den = w_inter * jnp.einsum('bhtd,bhd->bht', qc, n_vec) + jnp.sum(sc, axis=-1)
        h = num / jnp.maximum(jnp.abs(den), jnp.exp(-m_t))[..., None]
        b_last = bc[..., -1]
        logu = b_last[..., None] - bc + ic
        m_new = jnp.maximum(b_last + m, jnp.max(logu, axis=-1))
        decay = jnp.exp(b_last + m - m_new)
        u = jnp.exp(logu - m_new[..., None])
        c_mat = decay[..., None, None] * c_mat + jnp.einsum('bhs,bhsd,bhse->bhde', u, kc, vc)
        n_vec = decay[..., None] * n_vec + jnp.einsum('bhs,bhsd->bhd', u, kc)
        return (c_mat, n_vec, m_new), h

    init = (jnp.zeros((b, h_, dk, dv), jnp.float32), jnp.zeros((b, h_, dk), jnp.float32),
            jnp.zeros((b, h_), jnp.float32))
    _, h = lax.scan(step, init, (q, k, v, bcum, log_i))
    h = h.transpose(1, 0, 3, 2, 4).reshape(b, s, h_, dv)
    h = rms_norm(h, g_hnorm).reshape(b, s, MLSTM_V_WIDTH).astype(zq.dtype)
    return h * jax.nn.sigmoid(zo)


def cross_attend(u, mm, wq_c, wk_c, wv_c, g_cq, g_ck, wo_c):
    b, s, _ = u.shape
    n_mem = mm.shape[1]
    q = rms_norm((u @ wq_c).reshape(b, s, CROSS_HEADS, CROSS_HEAD_DIM), g_cq)
    k = rms_norm((mm @ wk_c).reshape(b, n_mem, CROSS_HEADS, CROSS_HEAD_DIM), g_ck)
    v = (mm @ wv_c).reshape(b, n_mem, CROSS_HEADS, CROSS_HEAD_DIM)
    sc = jnp.einsum('bqhd,bkhd->bhqk', q, k).astype(jnp.float32) * (CROSS_HEAD_DIM ** -0.5)
    p = jax.nn.softmax(sc, axis=-1).astype(v.dtype)
    o = jnp.einsum('bhqk,bkhd->bqhd', p, v).reshape(b, s, CROSS_WIDTH)
    return o @ wo_c


def conv_glu_ffn(u, w_up, conv_ffn, b_conv_ffn, w_down):
    h = causal_dwconv(u @ w_up, conv_ffn) + b_conv_ffn
    return (jax.nn.silu(h[..., :D_FF]) * h[..., D_FF:]) @ w_down


def hybrid_layer(x, mem, cos, sin, g_mix, w_in, g_qa, w_qb, g_kva, w_kvb, g_qn_nope, g_qn_pe,
                 g_kn_nope, g_kn_pe, conv_qk, b_if, g_hnorm, p_a, p_b, w_out, g_cross, g_mem,
                 wq_c, wk_c, wv_c, g_cq, g_ck, wo_c, g_ffn, w_up, conv_ffn, b_conv_ffn, w_down):
    split_points = [int(p) for p in np.cumsum(IN_SPLITS)[:-1]]
    z = rms_norm(x, g_mix) @ w_in
    z_qa, z_kv, z_kpe, zq, zk, zv, zi, zf, zo, gate_a, gate_b = jnp.split(z, split_points, axis=-1)
    y_a = mla_attention(z_qa, z_kv, z_kpe, cos, sin, g_qa, w_qb, g_kva, w_kvb,
                        g_qn_nope, g_qn_pe, g_kn_nope, g_kn_pe)
    y_b = mlstm(zq, zk, zv, zi, zf, zo, conv_qk, b_if, g_hnorm)
    merged = jax.nn.sigmoid(gate_a) * (y_a @ p_a) + jax.nn.sigmoid(gate_b) * (y_b @ p_b)
    x = x + merged @ w_out
    x = x + cross_attend(rms_norm(x, g_cross), rms_norm(mem, g_mem), wq_c, wk_c, wv_c, g_cq, g_ck, wo_c)
    x = x + conv_glu_ffn(rms_norm(x, g_ffn), w_up, conv_ffn, b_conv_ffn, w_down)
    return x


def setup_inputs(seed: int = 0) -> dict:
    key = jax.random.key(seed)
    ks = iter(jax.random.split(key, 64))
    f32 = jnp.float32

    def w(shape, fan_in):
        return jax.random.normal(next(ks), (DEPTH,) + shape, f32) * (fan_in ** -0.5)

    def gain(shape):
        return 1.0 + 0.05 * jax.random.normal(next(ks), (DEPTH,) + shape, f32)

    x = jax.random.normal(next(ks), (BATCH, SEQ, D_MODEL), f32)
    mem = jax.random.normal(next(ks), (BATCH, N_MEM, D_MODEL), f32)
    offset = jax.random.randint(next(ks), (BATCH, 1), 0, 4096, dtype=jnp.int32)
    positions = (offset + jnp.arange(SEQ, dtype=jnp.int32)[None, :]).astype(jnp.int32)
    b_i = 0.1 * jax.random.normal(next(ks), (DEPTH, MLSTM_HEADS), f32)
    b_f = jnp.linspace(3.0, 6.0, MLSTM_HEADS, dtype=f32)[None, :] + 0.1 * jax.random.normal(next(ks), (DEPTH, MLSTM_HEADS), f32)
    return {
        "x": x,
        "mem": mem,
        "positions": positions,
        "g_mix": gain((D_MODEL,)),
        "w_in": w((D_MODEL, IN_WIDTH), D_MODEL),
        "g_qa": gain((Q_LORA_RANK,)),
        "w_qb": w((Q_LORA_RANK, MLA_HEADS * (QK_NOPE_DIM + QK_ROPE_DIM)), Q_LORA_RANK),
        "g_kva": gain((KV_LORA_RANK,)),
        "w_kvb": w((KV_LORA_RANK, MLA_HEADS * (QK_NOPE_DIM + V_HEAD_DIM)), KV_LORA_RANK),
        "g_qn_nope": gain((QK_NOPE_DIM,)),
        "g_qn_pe": gain((QK_ROPE_DIM,)),
        "g_kn_nope": gain((QK_NOPE_DIM,)),
        "g_kn_pe": gain((QK_ROPE_DIM,)),
        "conv_qk": w((MLSTM_CONV, 2 * MLSTM_QK_WIDTH), MLSTM_CONV),
        "b_if": jnp.concatenate([b_i, b_f], axis=-1),
        "g_hnorm": gain((MLSTM_HEADS, MLSTM_V_DIM)),
        "p_a": w((MLA_WIDTH, D_MODEL), MLA_WIDTH),
        "p_b": w((MLSTM_V_WIDTH, D_MODEL), MLSTM_V_WIDTH),
        "w_out": w((D_MODEL, D_MODEL), D_MODEL),
        "g_cross": gain((D_MODEL,)),
        "g_mem": gain((D_MODEL,)),
        "wq_c": w((D_MODEL, CROSS_WIDTH), D_MODEL),
        "wk_c": w((D_MODEL, CROSS_WIDTH), D_MODEL),
        "wv_c": w((D_MODEL, CROSS_WIDTH), D_MODEL),
        "g_cq": gain((CROSS_HEAD_DIM,)),
        "g_ck": gain((CROSS_HEAD_DIM,)),
        "wo_c": w((CROSS_WIDTH, D_MODEL), CROSS_WIDTH),
        "g_ffn": gain((D_MODEL,)),
        "w_up": w((D_MODEL, 2 * D_FF), D_MODEL),
        "conv_ffn": w((FFN_CONV, 2 * D_FF), FFN_CONV),
        "b_conv_ffn": 0.01 * jax.random.normal(next(ks), (DEPTH, 2 * D_FF), f32),
        "w_down": w((D_FF, D_MODEL), D_FF),
    }


def reference(x, mem, positions, g_mix, w_in, g_qa, w_qb, g_kva, w_kvb, g_qn_nope, g_qn_pe,
              g_kn_nope, g_kn_pe, conv_qk, b_if, g_hnorm, p_a, p_b, w_out, g_cross, g_mem,
              wq_c, wk_c, wv_c, g_cq, g_ck, wo_c, g_ffn, w_up, conv_ffn, b_conv_ffn, w_down):
    cos, sin = rope_tables(positions)
    for l in range(DEPTH):
        x = hybrid_layer(x, mem, cos, sin, g_mix[l], w_in[l], g_qa[l], w_qb[l], g_kva[l], w_kvb[l],
                         g_qn_nope[l], g_qn_pe[l], g_kn_nope[l], g_kn_pe[l], conv_qk[l], b_if[l],
                         g_hnorm[l], p_a[l], p_b[l], w_out[l], g_cross[l], g_mem[l], wq_c[l], wk_c[l],
                         wv_c[l], g_cq[l], g_ck[l], wo_c[l], g_ffn[l], w_up[l], conv_ffn[l],
                         b_conv_ffn[l], w_down[l])
    return x
```

```cpp
#include <hip/hip_runtime.h>
#include <hip/hip_cooperative_groups.h>
#include <cstdio>
#include <cstdint>
#include <cmath>
namespace cg = cooperative_groups;
namespace pg8 {
#define PG8_LAS __attribute__((address_space(3)))
typedef unsigned short bf16_t;
typedef short bf16x8 __attribute__((ext_vector_type(8)));
typedef float f32x4 __attribute__((ext_vector_type(4)));
typedef unsigned u32x4 __attribute__((ext_vector_type(4)));
constexpr int BM = 256, BK = 64, HALF = 128, HTB = HALF * BK * 2  , STAGE_BYTES = 8 * HTB, NXCD = 8, WGM = 8;

__host__ __device__ __forceinline__ int lds_byte(int r, int c) { const int st = (r >> 4) * 2 + (c >> 5), rr = r & 15, cc = c & 31, ob = rr * 64 + cc * 2; return st * 1024 + (ob ^ (((ob >> 9) & 1) << 5)); }
__host__ __device__ __forceinline__ void stage_rc(int b, int& R, int& C) { const int st = b / 1024, sb = b % 1024, swz = sb ^ (((sb >> 9) & 1) << 5); R = (st >> 1) * 16 + swz / 64; C = (st & 1) * 32 + (swz % 64) / 2; }
__host__ __device__ __forceinline__ int perm32(int rho) { const int n = rho >> 4, i = rho & 15; return 8 * (i >> 2) + 4 * n + (i & 3); }

struct Unit { int pm, pn; };
struct Gemm { const bf16_t* A; const bf16_t* Bt; int M, N, K, lda; };

struct StaticOrder {
    int nM, nN, nwg, G, c;
    __host__ __device__ void init(int M, int N, int G_, int c_) { nM = M / BM; nN = N / BM; nwg = nM * nN; G = G_; c = c_; }
    __host__ __device__ bool next(int i, Unit& u) const {
        const long L = (long)i * G + c; if (L >= nwg) return false;
        int wgid = (int)L; { const int q = nwg / NXCD, r = nwg % NXCD, xcd = wgid % NXCD, off = wgid / NXCD; wgid = (xcd < r ? xcd * (q + 1) : r * (q + 1) + (xcd - r) * q) + off; }
        const int nig = WGM * nN, gid = wgid / nig, fm = gid * WGM, gsz = (nM - fm) < WGM ? (nM - fm) : WGM;
        u.pm = fm + ((wgid % nig) % gsz); u.pn = (wgid % nig) / gsz; return true;
    }
    __device__ __forceinline__ void a_ready(const Unit&) const {}
    __device__ __forceinline__ void done(const Unit&) const {}
};

__device__ __forceinline__ unsigned cvt_pk_bf16(float lo, float hi) { unsigned r; asm volatile("v_cvt_pk_bf16_f32 %0, %1, %2" : "=v"(r) : "v"(lo), "v"(hi)); return r; }
template <class Epi, class Sched, bool ALIGN_EPI = false, bool SP2 = false>
__device__ __forceinline__ void gemm_phase(PG8_LAS unsigned char* lds, int tid_in, const Gemm g, const Sched& S, const Epi& E) {
    int tid_ = tid_in; asm volatile("" : "+v"(tid_));
    const int tid = tid_, wid = __builtin_amdgcn_readfirstlane(tid >> 6), lane = tid & 63, wr = wid >> 2, wc = wid & 3, fr = lane & 15, fq = lane >> 4;
    const int K = g.K, nt = K / BK;
    unsigned voffA[2], voffB[2];
#pragma unroll
    for (int i = 0; i < 2; ++i) { int R, C; stage_rc(tid * 16 + i * 8192, R, C); const int Rb = Epi::PERM ? ((R & ~31) + perm32(R & 31)) : R;
        voffA[i] = (unsigned)(R * g.lda + C) * 2u; voffB[i] = (unsigned)(Rb * K + C) * 2u; }
    const size_t kstep = (size_t)(BK * 2);
    const size_t hstepA = (size_t)HALF * g.lda * 2, hstepB = (size_t)HALF * K * 2;
    const size_t tstepA = 2 * hstepA, tstepB = 2 * hstepB;
    const unsigned ldsw = (unsigned)wid * 1024u;
    const int aoff = lds_byte(wr * 64 + fr, fq * 8), boff = lds_byte(wc * 32 + fr, fq * 8);
#define PG8_SA(b, h) (((b) * 2 + (h)) * HTB)
#define PG8_SB(b, h) ((4 + (b) * 2 + (h)) * HTB)
#define PG8_STAGE(bufoff, gbase, voff) do { _Pragma("unroll") for (int _i = 0; _i < 2; ++_i) \
        __builtin_amdgcn_global_load_lds((const unsigned*)((const char*)(gbase) + (voff)[_i]), (PG8_LAS unsigned*)(lds + (bufoff) + ldsw + _i * 8192), 16, 0, 0); } while (0)
#define PG8_LDA(dst, b, h) do { _Pragma("unroll") for (int m = 0; m < 4; ++m) _Pragma("unroll") for (int k = 0; k < 2; ++k) dst[m][k] = *(const PG8_LAS bf16x8*)(lds + PG8_SA(b, h) + aoff + m * 2048 + k * 1024); } while (0)
#define PG8_LDB(dst, b, h) do { _Pragma("unroll") for (int n = 0; n < 2; ++n) _Pragma("unroll") for (int k = 0; k < 2; ++k) dst[n][k] = *(const PG8_LAS bf16x8*)(lds + PG8_SB(b, h) + boff + n * 2048 + k * 1024); } while (0)
#define PG8_MMA(ai, bj, At, Bt) do { __builtin_amdgcn_s_setprio(1); _Pragma("unroll") for (int m = 0; m < 4; ++m) _Pragma("unroll") for (int n = 0; n < 2; ++n) _Pragma("unroll") for (int k = 0; k < 2; ++k) \
        acc[ai][bj][m][n] = __builtin_amdgcn_mfma_f32_16x16x32_bf16(Bt[n][k], At[m][k], acc[ai][bj][m][n], 0, 0, 0); __builtin_amdgcn_s_setprio(0); } while (0)
#define PG8_WAIT_V(n) asm volatile("s_waitcnt vmcnt(" #n ")" ::: "memory")
#define PG8_WAIT_L(n) asm volatile("s_waitcnt lgkmcnt(" #n ")" ::: "memory")
#define PG8_BAR __builtin_amdgcn_s_barrier()
#define PG8_SCHED __builtin_amdgcn_sched_barrier(0)
    Unit cur, nxt; int ui = 0;
    if (!S.next(0, cur)) return;
    f32x4 acc[2][2][4][2];
#pragma unroll
    for (int a = 0; a < 2; ++a)
#pragma unroll
        for (int b = 0; b < 2; ++b)
#pragma unroll
            for (int m = 0; m < 4; ++m)
#pragma unroll
                for (int n = 0; n < 2; ++n) acc[a][b][m][n] = (f32x4){0.f, 0.f, 0.f, 0.f};
    bf16x8 At[4][2], B0[2][2], B1[2][2];
    const char* cA = (const char*)g.A + (size_t)cur.pm * tstepA; const char* cB = (const char*)g.Bt + (size_t)cur.pn * tstepB;
    S.a_ready(cur);
    if constexpr (SP2) {
        PG8_STAGE(PG8_SB(0, 0), cB, voffB); PG8_STAGE(PG8_SB(0, 1), cB + hstepB, voffB); PG8_STAGE(PG8_SA(0, 0), cA, voffA); PG8_STAGE(PG8_SA(0, 1), cA + hstepA, voffA);
        if (wr == 1) PG8_BAR;
        PG8_WAIT_V(2); PG8_BAR;
        PG8_STAGE(PG8_SB(1, 0), cB + kstep, voffB); PG8_STAGE(PG8_SA(1, 0), cA + kstep, voffA); PG8_STAGE(PG8_SB(1, 1), cB + hstepB + kstep, voffB);
        PG8_WAIT_V(6); PG8_BAR;
    } else {
        PG8_STAGE(PG8_SB(0, 0), cB, voffB); PG8_STAGE(PG8_SA(0, 0), cA, voffA); PG8_STAGE(PG8_SB(0, 1), cB + hstepB, voffB); PG8_STAGE(PG8_SA(0, 1), cA + hstepA, voffA);
        if (wr == 1) PG8_BAR;
        PG8_WAIT_V(4); PG8_BAR;
        PG8_STAGE(PG8_SB(1, 0), cB + kstep, voffB); PG8_STAGE(PG8_SA(1, 0), cA + kstep, voffA); PG8_STAGE(PG8_SB(1, 1), cB + hstepB + kstep, voffB);
        PG8_WAIT_V(6); PG8_BAR;
    }
    for (;;) {
        const bool has_next = S.next(ui + 1, nxt);
        const char* nA = has_next ? (const char*)g.A + (size_t)nxt.pm * tstepA : cA; const char* nB = has_next ? (const char*)g.Bt + (size_t)nxt.pn * tstepB : cB;
        for (int t = 0; t < nt; t += 2) {
            const bool last = (t == nt - 2);
            const char* a1 = cA + (size_t)(t + 1) * kstep;
            const char* a2 = last ? nA : cA + (size_t)(t + 2) * kstep; const char* b2 = last ? nB : cB + (size_t)(t + 2) * kstep;
            const char* a3 = a2 + kstep; const char* b3 = b2 + kstep;
            if (last && has_next) S.a_ready(nxt);
            if constexpr (SP2) {
            PG8_LDB(B0, 0, 0); PG8_LDB(B1, 0, 1); PG8_SCHED; PG8_LDA(At, 0, 0); PG8_STAGE(PG8_SA(1, 1), a1 + hstepA, voffA);
            PG8_WAIT_V(8); PG8_WAIT_L(0); PG8_BAR; PG8_MMA(0, 0, At, B0); PG8_MMA(0, 1, At, B1); PG8_BAR; PG8_SCHED;
            PG8_LDA(At, 0, 1); PG8_STAGE(PG8_SB(0, 0), b2, voffB); PG8_STAGE(PG8_SB(0, 1), b2 + hstepB, voffB); PG8_STAGE(PG8_SA(0, 0), a2, voffA);
            PG8_WAIT_V(8); PG8_WAIT_L(0); PG8_BAR; PG8_MMA(1, 0, At, B0); PG8_MMA(1, 1, At, B1); PG8_BAR; PG8_SCHED;
            PG8_LDB(B0, 1, 0); PG8_LDB(B1, 1, 1); PG8_SCHED; PG8_LDA(At, 1, 0); PG8_STAGE(PG8_SA(0, 1), a2 + hstepA, voffA);
            PG8_WAIT_V(8); PG8_WAIT_L(0); PG8_BAR; PG8_MMA(0, 0, At, B0); PG8_MMA(0, 1, At, B1); PG8_BAR; PG8_SCHED;
            PG8_LDA(At, 1, 1); PG8_STAGE(PG8_SB(1, 0), b3, voffB); PG8_STAGE(PG8_SB(1, 1), b3 + hstepB, voffB); PG8_STAGE(PG8_SA(1, 0), a3, voffA);
            PG8_WAIT_V(8); PG8_WAIT_L(0); PG8_BAR; PG8_MMA(1, 0, At, B0); PG8_MMA(1, 1, At, B1); PG8_BAR; PG8_SCHED;
            } else {
            PG8_LDB(B0, 0, 0); PG8_SCHED; PG8_LDA(At, 0, 0); PG8_STAGE(PG8_SA(1, 1), a1 + hstepA, voffA);
            PG8_WAIT_L(8); PG8_BAR; PG8_WAIT_L(0); PG8_MMA(0, 0, At, B0); PG8_BAR; PG8_SCHED;
            PG8_LDB(B1, 0, 1); PG8_STAGE(PG8_SB(0, 0), b2, voffB);
            PG8_BAR; PG8_WAIT_L(0); PG8_MMA(0, 1, At, B1); PG8_BAR;
            PG8_LDA(At, 0, 1); PG8_STAGE(PG8_SA(0, 0), a2, voffA);
            PG8_BAR; PG8_WAIT_L(0); PG8_MMA(1, 0, At, B0); PG8_BAR; PG8_SCHED;
            PG8_STAGE(PG8_SB(0, 1), b2 + hstepB, voffB);
            PG8_WAIT_V(6); PG8_BAR; PG8_MMA(1, 1, At, B1); PG8_BAR;
            PG8_LDB(B0, 1, 0); PG8_SCHED; PG8_LDA(At, 1, 0); PG8_STAGE(PG8_SA(0, 1), a2 + hstepA, voffA);
            PG8_WAIT_L(8); PG8_BAR; PG8_WAIT_L(0); PG8_MMA(0, 0, At, B0); PG8_BAR; PG8_SCHED;
            PG8_LDB(B1, 1, 1); PG8_STAGE(PG8_SB(1, 0), b3, voffB);
            PG8_BAR; PG8_WAIT_L(0); PG8_MMA(0, 1, At, B1); PG8_BAR;
            PG8_LDA(At, 1, 1); PG8_STAGE(PG8_SA(1, 0), a3, voffA);
            PG8_BAR; PG8_WAIT_L(0); PG8_MMA(1, 0, At, B0); PG8_BAR; PG8_SCHED;
            PG8_STAGE(PG8_SB(1, 1), b3 + hstepB, voffB);
            PG8_WAIT_V(6); PG8_BAR; PG8_MMA(1, 1, At, B1); PG8_BAR;
            }
        }
        if constexpr (ALIGN_EPI) { if (wr == 0) PG8_BAR; }
        if constexpr (!Epi::AFTER_DRAIN) { E(acc, cur, wr, wc, fr, fq); S.done(cur); }
        if (!has_next) break;
#pragma unroll
        for (int a = 0; a < 2; ++a)
#pragma unroll
            for (int b = 0; b < 2; ++b)
#pragma unroll
                for (int m = 0; m < 4; ++m)
#pragma unroll
                    for (int n = 0; n < 2; ++n) acc[a][b][m][n] = (f32x4){0.f, 0.f, 0.f, 0.f};
        cur = nxt; cA = nA; cB = nB; ++ui;
        if constexpr (ALIGN_EPI) { if (wr == 1) PG8_BAR; }
    }
    PG8_WAIT_V(0);
    if constexpr (!ALIGN_EPI) { if (wr == 0) PG8_BAR; }
    PG8_BAR;
    if constexpr (Epi::AFTER_DRAIN) { E.fused(acc, cur, wr, wc, fr, fq, lds, wid, lane); S.done(cur); }
#undef PG8_SA
#undef PG8_SB
#undef PG8_STAGE
#undef PG8_LDA
#undef PG8_LDB
#undef PG8_MMA
#undef PG8_WAIT_V
#undef PG8_WAIT_L
#undef PG8_BAR
#undef PG8_SCHED
}
}
#define LAS __attribute__((address_space(3)))
typedef unsigned short bf16_t;
typedef short bf16x8 __attribute__((ext_vector_type(8)));
typedef short s16x4 __attribute__((ext_vector_type(4)));
typedef float f32x4 __attribute__((ext_vector_type(4)));
typedef float f32x16 __attribute__((ext_vector_type(16)));
typedef unsigned u32x4 __attribute__((ext_vector_type(4)));
typedef unsigned u32x2 __attribute__((ext_vector_type(2)));

constexpr int MT = 16384, SEQL = 4096;
constexpr float EPSN = 1e-6f;
constexpr size_t MiB = (size_t)1 << 20;
constexpr size_t WS_SSQ_QA = 0, WS_SSQ_KV = 65536, WS_SSQ_X1 = 131072, WS_SSQ_X2 = 196608;
constexpr size_t WS_KC = 1 * MiB, WS_VC = 2 * MiB, WS_KPE = 4 * MiB;
constexpr size_t WS_WIN_T = 8 * MiB, WS_WQB_T = 53 * MiB, WS_WKVB_T = 56 * MiB, WS_PA_T = 60 * MiB, WS_PB_T = 68 * MiB, WS_WOUT_T = 76 * MiB;
constexpr size_t WS_WQC_T = 84 * MiB, WS_WKC_T = 86 * MiB, WS_WVC_T = 88 * MiB, WS_WOC_T = 90 * MiB, WS_MEMN = 92 * MiB;
constexpr size_t WS_Z1 = 96 * MiB, WS_U = 200 * MiB, WS_KN = 264 * MiB, WS_V = 328 * MiB, WS_YA = 392 * MiB, WS_ROPE = 456 * MiB;
constexpr size_t WS_Z2A = 264 * MiB, WS_YB = 200 * MiB, WS_TA = 96 * MiB, WS_X1B = 200 * MiB, WS_QC = 264 * MiB, WS_OC = 280 * MiB;
constexpr size_t WS_WUP_T = 8 * MiB, WS_WDN_T = 52 * MiB, WS_X2B = 426 * MiB, WS_H1 = 74 * MiB, WS_H2 = 250 * MiB, WS_NEED = 490 * MiB;
constexpr size_t WS_WING = 481 * MiB;
constexpr size_t WS_SC = 460 * MiB, WS_GV = 476 * MiB;
constexpr size_t O_QN = 0, O_QPE = 64 * MiB, O_Z2B = 0;
constexpr int Z1_LD = 3328, Z2_LD = 4096;
constexpr int LDS_BYTES = 147456, LDS_EPI = 131072;
constexpr int NPHASE = 14;
constexpr size_t WS_BAR = 6 * MiB, BAR_BYTES = 16384;
constexpr int LDS_MISC = LDS_BYTES - 64;
constexpr int NML = 32;

__device__ __forceinline__ float bf2f(unsigned short v) { return __uint_as_float(((unsigned)v) << 16); }
__device__ __forceinline__ float bflo(unsigned w) { return __uint_as_float(w << 16); }
__device__ __forceinline__ float bfhi(unsigned w) { return __uint_as_float(w & 0xffff0000u); }
__device__ __forceinline__ unsigned pk2(float lo, float hi) { return pg8::cvt_pk_bf16(lo, hi); }
__device__ __forceinline__ float wave_sum(float v) {
#pragma unroll
    for (int o = 1; o < 64; o <<= 1) v += __shfl_xor(v, o);
    return v;
}
__device__ __forceinline__ float sigm(float x) { return 1.f / (1.f + __expf(-x)); }
__device__ __forceinline__ void unpack8(const u32x4 w, float (&f)[8]) {
    f[0] = bflo(w.x); f[1] = bfhi(w.x); f[2] = bflo(w.y); f[3] = bfhi(w.y); f[4] = bflo(w.z); f[5] = bfhi(w.z); f[6] = bflo(w.w); f[7] = bfhi(w.w);
}
__device__ __forceinline__ u32x4 pack8(const float (&f)[8]) { u32x4 w; w.x = pk2(f[0], f[1]); w.y = pk2(f[2], f[3]); w.z = pk2(f[4], f[5]); w.w = pk2(f[6], f[7]); return w; }
#define LDS_WAIT() asm volatile("s_waitcnt lgkmcnt(0)" ::: "memory")

#define XB_TMO      128
#define XB_XCNT(j)  (256  + 64 * (j))
#define XB_XSUB(j)  (1280 + 64 * (j))
#define XB_XGEN(j)  (2304 + 64 * (j))
#define XB_TOP      3328
#define XB_TOPGEN   3392
#define XCD_BAR_WORDS 3456
#define XB_SPIN_CAP (1u << 18)

__device__ __forceinline__ unsigned xb_ld(unsigned* p)              { return __hip_atomic_load(p, __ATOMIC_RELAXED, __HIP_MEMORY_SCOPE_AGENT); }
__device__ __forceinline__ unsigned xb_add(unsigned* p, unsigned v) { return __hip_atomic_fetch_add(p, v, __ATOMIC_RELAXED, __HIP_MEMORY_SCOPE_AGENT); }
__device__ __forceinline__ unsigned xb_xcc_id() { return (unsigned)__builtin_amdgcn_s_getreg((3 << 11) | 20) & 0xFu; }
#define XB_SPIN(cond, bar) do { unsigned _sp = 0; while (cond) { __builtin_amdgcn_s_sleep(1); \
    if ((++_sp & 255u) == 0u) { if (xb_ld(&(bar)[XB_TMO])) break; if (_sp > XB_SPIN_CAP) { atomicAdd(&(bar)[XB_TMO], 1u); break; } } } } while (0)

struct XcdBarrier {
    unsigned* bar; unsigned x;
    volatile LAS unsigned* st;
};

__device__ __forceinline__ XcdBarrier xcd_barrier_post(unsigned* bar, volatile LAS unsigned* st) {
    XcdBarrier b; b.bar = bar; b.x = xb_xcc_id(); b.st = st;
    if (threadIdx.x == 0) (void)xb_add(&bar[XB_XCNT(b.x)], 1u);
    return b;
}
__device__ __forceinline__ void xcd_barrier_complete(unsigned* bar, unsigned x, unsigned& nloc, unsigned& nx) {
    const unsigned G = gridDim.x * gridDim.y * gridDim.z;
    unsigned sum, cnt, mine, sp = 0u;
    for (;;) {
        sum = 0u; cnt = 0u; mine = 0u;
#pragma unroll
        for (unsigned j = 0; j < 16; ++j) { const unsigned c = xb_ld(&bar[XB_XCNT(j)]); sum += c; cnt += (c > 0u) ? 1u : 0u; mine = (j == x) ? c : mine; }
        if (sum == G) break;
        __builtin_amdgcn_s_sleep(1);
        if ((++sp & 255u) == 0u) { if (xb_ld(&bar[XB_TMO])) break; if (sp > XB_SPIN_CAP) { atomicAdd(&bar[XB_TMO], 1u); break; } }
    }
    nloc = mine > 0u ? mine : 1u; nx = cnt > 0u ? cnt : 1u;
}

__device__ __forceinline__ void xcd_barrier(const XcdBarrier& b) {
    asm volatile("s_waitcnt vmcnt(0)" ::: "memory");
    __syncthreads();
    if (threadIdx.x == 0) {
        unsigned* bar = b.bar;
        __builtin_amdgcn_s_waitcnt(0);
        unsigned nloc = b.st[0], nx = b.st[1];
        if (nloc == 0u) { xcd_barrier_complete(bar, b.x, nloc, nx); b.st[0] = nloc; b.st[1] = nx; }
        const unsigned old = xb_add(&bar[XB_XSUB(b.x)], 1u);
        const unsigned gen = old / nloc;
        if (old + 1u == (gen + 1u) * nloc) {
            __builtin_amdgcn_fence(__ATOMIC_RELEASE, "agent");
            asm volatile("s_waitcnt vmcnt(0)" ::: "memory");
            const unsigned og = xb_add(&bar[XB_TOP], 1u);
            const unsigned tg = og / nx;
            if (og + 1u == (tg + 1u) * nx) xb_add(&bar[XB_TOPGEN], 1u);
            else XB_SPIN(xb_ld(&bar[XB_TOPGEN]) == tg, bar);
            __builtin_amdgcn_fence(__ATOMIC_ACQUIRE, "agent");
            xb_add(&bar[XB_XGEN(b.x)], 1u);
            asm volatile("s_waitcnt vmcnt(0)" ::: "memory");
        } else {
            XB_SPIN(xb_ld(&bar[XB_XGEN(b.x)]) == gen, bar);
            __builtin_amdgcn_fence(__ATOMIC_ACQUIRE, "agent");
            asm volatile("s_waitcnt vmcnt(0)" ::: "memory");
        }
    }
    __syncthreads();
}

struct Args { const float* in[32]; float* out; unsigned char* ws; int ph_lo, ph_hi; };
typedef const Args __attribute__((address_space(4)))* ArgsP;
enum { EM_Z1 = 0, EM_Z2, EM_ZG, EM_GA, EM_GB, EM_UP, EM_Q, EM_KV, EM_QC, EM_KC, EM_VC };
struct EpiBF {
    static constexpr bool PERM = true, AFTER_DRAIN = false;
    int mode; ArgsP a0; LAS float* P;
    __device__ __forceinline__ void operator()(const pg8::f32x4 (&acc)[2][2][4][2], const pg8::Unit& u, int wr, int wc, int fr, int fq) const {
        ArgsP a = a0; asm volatile("" : "+s"(a));
        unsigned char* ws = a->ws; unsigned char* ob = (unsigned char*)a->out;
        int kind = 0; bf16_t* dst = nullptr; int ldc = 2048, colb = u.pn * 256; bool sig = false, presc = false, addt = false; float* ssq = nullptr; const bf16_t* gt = nullptr; int gcol = 0;
        const float* rs_ssq = nullptr; float rs_invn = 0.f; const float* gain0 = nullptr; const float* gain1 = nullptr;
        const float* ropec = (const float*)(ws + WS_ROPE); const float* ropes = ropec + (size_t)MT * 32;
        switch (mode) {
            case EM_Z1: dst = (bf16_t*)(ws + WS_Z1); ldc = Z1_LD; ssq = u.pn < 2 ? (float*)(ws + WS_SSQ_QA) : (u.pn < 4 ? (float*)(ws + WS_SSQ_KV) : nullptr); break;
            case EM_Z2: ldc = Z2_LD; sig = u.pn >= 8; dst = (bf16_t*)(ws + WS_Z2A); break;
            case EM_ZG: ldc = Z2_LD; sig = true; dst = (bf16_t*)(ob + O_Z2B); break;
            case EM_GA: dst = (bf16_t*)(ws + WS_TA); gt = (const bf16_t*)(ob + O_Z2B); gcol = colb; break;
            case EM_GB: dst = (bf16_t*)(ws + WS_TA); gt = (const bf16_t*)(ob + O_Z2B); gcol = 2048 + colb; addt = true; break;
            case EM_UP: presc = true; rs_ssq = (const float*)(ws + WS_SSQ_X2); rs_invn = 1.f / 2048.f; ldc = 5632; if (u.pn >= 22) { dst = (bf16_t*)(ws + WS_H2); colb = (u.pn - 22) * 256; } else dst = (bf16_t*)(ws + WS_H1); break;
            case EM_Q: presc = true; rs_ssq = (const float*)(ws + WS_SSQ_QA); rs_invn = 1.f / 512.f; gain0 = a->in[9]; gain1 = a->in[10];
                       if (u.pn < 8) { kind = 1; dst = (bf16_t*)(ob + O_QN); } else { kind = 2; dst = (bf16_t*)(ob + O_QPE); ldc = 1024; colb = (u.pn - 8) * 256; } break;
            case EM_KV: presc = true; rs_ssq = (const float*)(ws + WS_SSQ_KV); rs_invn = 1.f / 512.f; gain0 = a->in[11];
                       if (u.pn < 8) { kind = 1; dst = (bf16_t*)(ws + WS_KN); } else { dst = (bf16_t*)(ws + WS_V); colb = (u.pn - 8) * 256; } break;
            case EM_QC: presc = true; rs_ssq = (const float*)(ws + WS_SSQ_X1); rs_invn = 1.f / 2048.f; gain0 = a->in[24]; kind = 1; ldc = 512; dst = (bf16_t*)(ws + WS_QC); break;
            case EM_KC: kind = 1; ldc = 512; gain0 = a->in[25]; dst = (bf16_t*)(ws + WS_KC); break;
            default: ldc = 512; dst = (bf16_t*)(ws + WS_VC); break;
        }
        const int rowb = u.pm * 256 + wr * 64 + fr;
        const int cl = wc * 32 + 8 * fq;
        float rs8[2][4];
#pragma unroll
        for (int ai = 0; ai < 2; ++ai)
#pragma unroll
            for (int m = 0; m < 4; ++m) rs8[ai][m] = presc ? rs_ssq[rowb + ai * 128 + m * 16] : 0.f;
#pragma unroll
        for (int ai = 0; ai < 2; ++ai)
#pragma unroll
            for (int m = 0; m < 4; ++m) rs8[ai][m] = presc ? rsqrtf(rs8[ai][m] * rs_invn + EPSN) : 1.f;
        if (kind == 1) {
#pragma unroll
            for (int ai = 0; ai < 2; ++ai)
#pragma unroll
                for (int m = 0; m < 4; ++m) {
                    const int rl = ai * 128 + wr * 64 + m * 16 + fr;
                    const float rsv = rs8[ai][m];
#pragma unroll
                    for (int bj = 0; bj < 2; ++bj) {
                        float s = 0.f;
#pragma unroll
                        for (int n = 0; n < 2; ++n)
#pragma unroll
                            for (int j = 0; j < 4; ++j) { const float v = acc[ai][bj][m][n][j] * rsv; s += v * v; }
                        s += __shfl_xor(s, 16); s += __shfl_xor(s, 32);
                        if (fq == 0) P[rl * 8 + bj * 4 + wc] = s;
                    }
                }
            LDS_WAIT(); __builtin_amdgcn_s_barrier(); asm volatile("" ::: "memory");
            float g8[8];
            { const f32x4 ga = *(const f32x4*)(gain0 + cl), gb = *(const f32x4*)(gain0 + cl + 4); g8[0] = ga[0]; g8[1] = ga[1]; g8[2] = ga[2]; g8[3] = ga[3]; g8[4] = gb[0]; g8[5] = gb[1]; g8[6] = gb[2]; g8[7] = gb[3]; }
#pragma unroll
            for (int ai = 0; ai < 2; ++ai)
#pragma unroll
                for (int m = 0; m < 4; ++m) {
                    const int rl = ai * 128 + wr * 64 + m * 16 + fr; const int row = u.pm * 256 + rl;
                    const float rsv = rs8[ai][m];
#pragma unroll
                    for (int bj = 0; bj < 2; ++bj) {
                        const f32x4 p4 = *(const LAS f32x4*)(P + rl * 8 + bj * 4);
                        const float rn = rsqrtf(((p4[0] + p4[1]) + (p4[2] + p4[3])) * (1.f / 128.f) + EPSN) * rsv;
                        float o[8];
#pragma unroll
                        for (int n = 0; n < 2; ++n)
#pragma unroll
                            for (int j = 0; j < 4; ++j) o[4 * n + j] = acc[ai][bj][m][n][j] * rn * g8[4 * n + j];
                        *(u32x4*)(dst + (size_t)row * ldc + colb + bj * 128 + cl) = pack8(o);
                    }
                    asm volatile("" ::: "memory");
                }
        } else if (kind == 2) {
            const int hq = 4 * (u.pn - 8) + wc;
#pragma unroll
            for (int ai = 0; ai < 2; ++ai)
#pragma unroll
                for (int m = 0; m < 4; ++m) {
                    const int row = rowb + ai * 128 + m * 16;
                    const float rsv = rs8[ai][m];
                    float s = 0.f;
#pragma unroll
                    for (int bj = 0; bj < 2; ++bj)
#pragma unroll
                        for (int n = 0; n < 2; ++n)
#pragma unroll
                            for (int j = 0; j < 4; ++j) { const float v = acc[ai][bj][m][n][j] * rsv; s += v * v; }
                    s += __shfl_xor(s, 16); s += __shfl_xor(s, 32);
                    const float rn = rsqrtf(s * (1.f / 64.f) + EPSN) * rsv;
                    bf16_t* p = dst + (size_t)row * 1024 + 64 * hq + 8 * fq;
#pragma unroll
                    for (int n = 0; n < 2; ++n) {
                        const f32x4 cc = *(const f32x4*)(ropec + (size_t)row * 32 + 8 * fq + 4 * n), ss = *(const f32x4*)(ropes + (size_t)row * 32 + 8 * fq + 4 * n);
                        const f32x4 ga = *(const f32x4*)(gain1 + 8 * fq + 4 * n), gb = *(const f32x4*)(gain1 + 32 + 8 * fq + 4 * n);
                        float o1[4], o2[4];
#pragma unroll
                        for (int j = 0; j < 4; ++j) {
                            const float x1 = acc[ai][0][m][n][j] * rn * ga[j], x2 = acc[ai][1][m][n][j] * rn * gb[j];
                            o1[j] = x1 * cc[j] - x2 * ss[j]; o2[j] = x2 * cc[j] + x1 * ss[j];
                        }
                        u32x2 w1, w2; w1.x = pk2(o1[0], o1[1]); w1.y = pk2(o1[2], o1[3]); w2.x = pk2(o2[0], o2[1]); w2.y = pk2(o2[2], o2[3]);
                        *(u32x2*)(p + 4 * n) = w1; *(u32x2*)(p + 32 + 4 * n) = w2;
                        asm volatile("" ::: "memory");
                    }
                }
        } else {
#pragma unroll
            for (int ai = 0; ai < 2; ++ai)
#pragma unroll
                for (int m = 0; m < 4; ++m) {
                    const int row = rowb + ai * 128 + m * 16;
                    const float rsv = rs8[ai][m];
                    float sacc = 0.f;
#pragma unroll
                    for (int bj = 0; bj < 2; ++bj) {
                        float o[8];
#pragma unroll
                        for (int n = 0; n < 2; ++n)
#pragma unroll
                            for (int j = 0; j < 4; ++j) o[4 * n + j] = acc[ai][bj][m][n][j] * rsv;
                        if (sig) {
#pragma unroll
                            for (int e = 0; e < 8; ++e) o[e] = sigm(o[e]);
                        }
                        if (gt) { float gv[8]; unpack8(*(const u32x4*)(gt + (size_t)row * Z2_LD + gcol + bj * 128 + cl), gv);
#pragma unroll
                            for (int e = 0; e < 8; ++e) o[e] *= gv[e]; }
                        bf16_t* p = dst + (size_t)row * ldc + colb + bj * 128 + cl;
                        if (addt) { float tv[8]; unpack8(*(const u32x4*)p, tv);
#pragma unroll
                            for (int e = 0; e < 8; ++e) o[e] += tv[e]; }
                        if (ssq) {
#pragma unroll
                            for (int e = 0; e < 8; ++e) sacc += o[e] * o[e]; }
                        if (mode == EM_UP) __builtin_nontemporal_store(pack8(o), (u32x4*)p); else *(u32x4*)p = pack8(o);
                    }
                    if (ssq) { sacc += __shfl_xor(sacc, 16); sacc += __shfl_xor(sacc, 32); if (fq == 0) atomicAdd(ssq + row, sacc); }
                    asm volatile("" ::: "memory");
                }
        }
    }
};
struct EpiF32 {
    static constexpr bool PERM = false, AFTER_DRAIN = false;
    int mode; ArgsP a0;
    __device__ __forceinline__ void operator()(const pg8::f32x4 (&acc)[2][2][4][2], const pg8::Unit& u, int wr, int wc, int fr, int fq) const {
        ArgsP a = a0; asm volatile("" : "+s"(a));
        unsigned char* ws = a->ws; float* out = a->out; const float* base = mode == 0 ? a->in[0] : (const float*)out;
        bf16_t* aux = mode == 0 ? (bf16_t*)(ws + WS_X1B) : mode == 1 ? (bf16_t*)(ws + WS_X2B) : nullptr; float* ssq = mode == 0 ? (float*)(ws + WS_SSQ_X1) : (float*)(ws + WS_SSQ_X2);
        const int rowb = u.pm * 256 + wr * 64 + fr, cb = u.pn * 256 + wc * 32 + 4 * fq;
#pragma unroll
        for (int ai = 0; ai < 2; ++ai) {
            f32x4 pre[4][2][2];
#pragma unroll
            for (int m = 0; m < 4; ++m)
#pragma unroll
                for (int bj = 0; bj < 2; ++bj)
#pragma unroll
                    for (int n = 0; n < 2; ++n) pre[m][bj][n] = *(const f32x4*)(base + (size_t)(rowb + ai * 128 + m * 16) * 2048 + cb + bj * 128 + n * 16);
#pragma unroll
            for (int m = 0; m < 4; ++m) {
                const int row = rowb + ai * 128 + m * 16; float s = 0.f;
#pragma unroll
                for (int bj = 0; bj < 2; ++bj)
#pragma unroll
                    for (int n = 0; n < 2; ++n) {
                        const size_t off = (size_t)row * 2048 + cb + bj * 128 + n * 16;
                        const f32x4 o = pre[m][bj][n] + acc[ai][bj][m][n];
                        *(f32x4*)(out + off) = o;
                        if (aux) { s += (o[0] * o[0] + o[1] * o[1]) + (o[2] * o[2] + o[3] * o[3]); u32x2 w; w.x = pk2(o[0], o[1]); w.y = pk2(o[2], o[3]); *(u32x2*)(aux + off) = w; }
                    }
                if (aux) { s += __shfl_xor(s, 16); s += __shfl_xor(s, 32); if (fq == 0) atomicAdd(ssq + row, s); }
            }
            asm volatile("" ::: "memory");
        }
    }
};
#define MFMA32(a, b, c) __builtin_amdgcn_mfma_f32_32x32x16_bf16((a), (b), (c), 0, 0, 0)
typedef short v4i16_t __attribute__((ext_vector_type(4)));
__device__ __forceinline__ s16x4 trread(const LAS unsigned char* p) { return __builtin_bit_cast(s16x4, __builtin_amdgcn_ds_read_tr16_b64_v4i16((LAS v4i16_t*)p)); }
__device__ __forceinline__ bf16x8 cat44(s16x4 lo, s16x4 hi) { return (bf16x8){lo[0], lo[1], lo[2], lo[3], hi[0], hi[1], hi[2], hi[3]}; }
__device__ __forceinline__ bf16x8 packacc8(const f32x16& x, int b) {
    u32x4 w; w.x = pk2(x[b], x[b + 1]); w.y = pk2(x[b + 2], x[b + 3]); w.z = pk2(x[b + 4], x[b + 5]); w.w = pk2(x[b + 6], x[b + 7]); return __builtin_bit_cast(bf16x8, w);
}
template <int NKS, bool ALLIN = false>
__device__ __forceinline__ void attn_unit(LAS unsigned char* lds, int tid_in, const bf16_t* qn, int ldqn, const bf16_t* qpe, int ldqpe, const bf16_t* kn, int ldkn, const bf16_t* kpe, int ldkpe,
                                          const bf16_t* vv, int ldv, bf16_t* out, int ldo, int NT, int my_nt, float c2) {
    constexpr int KSTR = NKS * 32 + 16, VSTR = ALLIN ? 288 : 320, KBUF = 64 * KSTR, VBUF = 64 * VSTR, NKB = ALLIN ? 4 : 2;
    int tid_ = tid_in; asm volatile("" : "+v"(tid_)); const int tid = tid_, lane = tid & 63, wid = __builtin_amdgcn_readfirstlane(tid >> 6), r = lane & 31, hh = lane >> 5;
    bf16x8 qf[NKS];
#pragma unroll
    for (int ks = 0; ks < NKS; ++ks) {
        if (ks < 8) qf[ks] = *(const bf16x8*)(qn + (size_t)(wid * 32 + r) * ldqn + ks * 16 + hh * 8);
        else qf[ks] = *(const bf16x8*)(qpe + (size_t)(wid * 32 + r) * ldqpe + (ks - 8) * 16 + hh * 8);
    }
    const int key0 = tid >> 4, ch0 = tid & 15;
    const int keyp = tid >> 3, chp = tid & 7;
    u32x4 rk0, rk1, rkp, rv0, rv1;
#define ATT_LOAD(t) do { const size_t kb_ = (size_t)(t) * 64; \
        rk0 = *(const u32x4*)(kn + (kb_ + key0) * ldkn + ch0 * 8); rk1 = *(const u32x4*)(kn + (kb_ + key0 + 32) * ldkn + ch0 * 8); \
        if (NKS > 8) rkp = *(const u32x4*)(kpe + (kb_ + keyp) * ldkpe + chp * 8); \
        rv0 = *(const u32x4*)(vv + (kb_ + key0) * ldv + ch0 * 8); rv1 = *(const u32x4*)(vv + (kb_ + key0 + 32) * ldv + ch0 * 8); } while (0)
#define ATT_STORE(buf) do { LAS unsigned char* kb_ = lds + (buf) * KBUF; LAS unsigned char* vb_ = lds + NKB * KBUF + (buf) * VBUF; \
        *(LAS u32x4*)(kb_ + key0 * KSTR + ch0 * 16) = rk0; *(LAS u32x4*)(kb_ + (key0 + 32) * KSTR + ch0 * 16) = rk1; \
        if (NKS > 8) *(LAS u32x4*)(kb_ + keyp * KSTR + 256 + chp * 16) = rkp; \
        *(LAS u32x4*)(vb_ + key0 * VSTR + ch0 * 16) = rv0; *(LAS u32x4*)(vb_ + (key0 + 32) * VSTR + ch0 * 16) = rv1; } while (0)
    if constexpr (ALLIN) {
        u32x4 ak0[4], ak1[4], av0[4], av1[4];
#pragma unroll
        for (int t = 0; t < 4; ++t) { ATT_LOAD(t); ak0[t] = rk0; ak1[t] = rk1; av0[t] = rv0; av1[t] = rv1; }
#pragma unroll
        for (int t = 0; t < 4; ++t) { rk0 = ak0[t]; rk1 = ak1[t]; rv0 = av0[t]; rv1 = av1[t]; ATT_STORE(t); }
    } else { ATT_LOAD(0); ATT_STORE(0); }
    __syncthreads();
    f32x16 o[4];
#pragma unroll
    for (int d = 0; d < 4; ++d)
#pragma unroll
        for (int i = 0; i < 16; ++i) o[d][i] = 0.f;
    float mrun = -INFINITY, lrun = 0.f;
    const int g4 = lane >> 4, i16 = lane & 15, q4 = i16 >> 2, p4 = i16 & 3;
    const int vlane = (4 * hh + q4) * VSTR + (16 * (g4 & 1) + 4 * p4) * 2;
#pragma nounroll
    for (int t = 0; t < NT; ++t) {
        if (!ALLIN && t + 1 < NT) ATT_LOAD(t + 1);
        if (t < my_nt) {
            const int bi_ = ALLIN ? t : (t & 1);
            const LAS unsigned char* Kb = lds + bi_ * KBUF; const LAS unsigned char* Vb = lds + NKB * KBUF + bi_ * VBUF;
            f32x16 s0, s1;
#pragma unroll
            for (int i = 0; i < 16; ++i) { s0[i] = 0.f; s1[i] = 0.f; }
            bf16x8 ka[2][2][2];
#define ATT_LDK(buf, g) do { _Pragma("unroll") for (int kk = 0; kk < 2; ++kk) { \
                ka[buf][kk][0] = *(const LAS bf16x8*)(Kb + r * KSTR + (2 * (g) + kk) * 32 + hh * 16); ka[buf][kk][1] = *(const LAS bf16x8*)(Kb + (32 + r) * KSTR + (2 * (g) + kk) * 32 + hh * 16); } } while (0)
            ATT_LDK(0, 0); ATT_LDK(1, 1);
            __builtin_amdgcn_sched_barrier(0);
#pragma unroll
            for (int g = 0; g < NKS / 2; ++g) {
#pragma unroll
                for (int kk = 0; kk < 2; ++kk) { s0 = MFMA32(ka[g & 1][kk][0], qf[2 * g + kk], s0); s1 = MFMA32(ka[g & 1][kk][1], qf[2 * g + kk], s1); }
                __builtin_amdgcn_sched_barrier(0);
                if (g + 2 < NKS / 2) { ATT_LDK(g & 1, g + 2); __builtin_amdgcn_sched_barrier(0); }
            }
#undef ATT_LDK
            s16x4 vl[2][4], vh[2][4];
#define ATT_LDV(buf, d) do { _Pragma("unroll") for (int kb = 0; kb < 2; ++kb) _Pragma("unroll") for (int s = 0; s < 2; ++s) { \
                const LAS unsigned char* p_ = Vb + vlane + (32 * kb + 16 * s) * VSTR + (d) * 64; vl[buf][2 * kb + s] = trread(p_); vh[buf][2 * kb + s] = trread(p_ + 8 * VSTR); } } while (0)
            ATT_LDV(0, 0); ATT_LDV(1, 1);
            __builtin_amdgcn_sched_barrier(0);
            float mx = -INFINITY;
#pragma unroll
            for (int i = 0; i < 16; ++i) mx = fmaxf(mx, fmaxf(s0[i], s1[i]));
            mx = fmaxf(mx, __shfl_xor(mx, 32)) * c2;
            const float mnew = fmaxf(mrun, mx), alpha = __builtin_amdgcn_exp2f(mrun - mnew); mrun = mnew;
            float ls = 0.f;
#pragma unroll
            for (int i = 0; i < 16; ++i) { s0[i] = __builtin_amdgcn_exp2f(fmaf(s0[i], c2, -mnew)); s1[i] = __builtin_amdgcn_exp2f(fmaf(s1[i], c2, -mnew)); ls += s0[i] + s1[i]; }
            lrun = lrun * alpha + ls;
#pragma unroll
            for (int d = 0; d < 4; ++d)
#pragma unroll
                for (int i = 0; i < 16; ++i) o[d][i] *= alpha;
            bf16x8 pf[4];
            pf[0] = packacc8(s0, 0); pf[1] = packacc8(s0, 8); pf[2] = packacc8(s1, 0); pf[3] = packacc8(s1, 8);
            __builtin_amdgcn_sched_barrier(0);
#pragma unroll
            for (int d = 0; d < 4; ++d) {
#pragma unroll
                for (int j = 0; j < 4; ++j) o[d] = MFMA32(cat44(vl[d & 1][j], vh[d & 1][j]), pf[j], o[d]);
                __builtin_amdgcn_sched_barrier(0);
                if (d + 2 < 4) { ATT_LDV(d & 1, d + 2); __builtin_amdgcn_sched_barrier(0); }
            }
#undef ATT_LDV
        }
        if constexpr (!ALLIN) { if (t + 1 < NT) ATT_STORE((t + 1) & 1); __syncthreads(); }
    }
    if constexpr (ALLIN) __syncthreads();
    const float lt = lrun + __shfl_xor(lrun, 32), inv = 1.f / lt;
#pragma unroll
    for (int d = 0; d < 4; ++d)
#pragma unroll
        for (int g = 0; g < 4; ++g) {
            u32x2 w; w.x = pk2(o[d][4 * g] * inv, o[d][4 * g + 1] * inv); w.y = pk2(o[d][4 * g + 2] * inv, o[d][4 * g + 3] * inv);
            *(u32x2*)(out + (size_t)(wid * 32 + r) * ldo + d * 32 + 8 * g + 4 * hh) = w;
        }
#undef ATT_LOAD
#undef ATT_STORE
}

constexpr size_t GV_WI = WS_GV, GV_EI = WS_GV + 512 * 1024, GV_A = WS_GV + 1024 * 1024, GV_R = WS_GV + 1536 * 1024, GV_U = WS_GV + 2048 * 1024, GV_DI = WS_GV + 2560 * 1024,
                 GV_DEC = WS_GV + 3072 * 1024, GV_DN = WS_GV + 3072 * 1024 + 65536;
__device__ __forceinline__ void gate_scan(LAS unsigned char* lds, int tid_in, int b, int h, const bf16_t* z1, const float* b_if, unsigned char* ws) {
    float* WIg = (float*)(ws + GV_WI); float* EIg = (float*)(ws + GV_EI); float* Ag = (float*)(ws + GV_A); float* Rg = (float*)(ws + GV_R); float* Ug = (float*)(ws + GV_U); float* DECg = (float*)(ws + GV_DEC);
    LAS float* BL = (LAS float*)lds; LAS float* PL = BL + 64; LAS float* MC = BL + 128;
    int tid_ = tid_in; asm volatile("" : "+v"(tid_)); const int tid = tid_, lane = tid & 63, wid = __builtin_amdgcn_readfirstlane(tid >> 6);
    const float bi = b_if[h], bfb = b_if[8 + h];
    const bf16_t* zp = z1 + ((size_t)b * SEQL + lane) * Z1_LD + 1088 + h;
    unsigned short ri[8], rf[8];
#pragma unroll
    for (int j = 0; j < 8; ++j) { const size_t c = wid * 8 + j; ri[j] = zp[c * 64 * Z1_LD]; rf[j] = zp[c * 64 * Z1_LD + 8]; }
    float bc[8], av[8], pm[8];
#pragma unroll
    for (int j = 0; j < 8; ++j) {
        const float gi = bf2f(ri[j]) + bi, xf = bf2f(rf[j]) + bfb;
        const float lf = fminf(xf, 0.f) - log1pf(__expf(-fabsf(xf)));
        float bcum = lf;
#pragma unroll
        for (int o = 1; o < 64; o <<= 1) { const float t = __shfl_up(bcum, o); if (lane >= o) bcum += t; }
        const float a = gi - bcum;
        float p = a;
#pragma unroll
        for (int o = 1; o < 64; o <<= 1) { const float t = __shfl_up(p, o); if (lane >= o) p = fmaxf(p, t); }
        bc[j] = bcum; av[j] = a; pm[j] = p;
        if (lane == 63) { BL[wid * 8 + j] = bcum; PL[wid * 8 + j] = p; }
    }
    __syncthreads();
    if (wid == 0) { float mcar = 0.f;
#pragma nounroll
        for (int c = 0; c < 64; ++c) { if (lane == 0) MC[c] = mcar; mcar = BL[c] + fmaxf(mcar, PL[c]); } }
    __syncthreads();
#pragma unroll
    for (int j = 0; j < 8; ++j) {
        const int c = wid * 8 + j; const size_t tok = (size_t)b * SEQL + c * 64 + lane;
        const float mcar = MC[c], mm = fmaxf(mcar, pm[j]), mrel = fmaxf(mcar, PL[c]);
        WIg[tok * 8 + h] = __expf(mcar - mm); EIg[tok * 8 + h] = __expf(-(bc[j] + mm)); Ag[tok * 8 + h] = av[j]; Rg[tok * 8 + h] = -mm; Ug[tok * 8 + h] = __expf(av[j] - mrel);
        if (lane == 0) DECg[(b * 8 + h) * 64 + c] = __expf(mcar - mrel);
    }
    __syncthreads();
}
__device__ __forceinline__ void mlstm_pre_unit(LAS unsigned char* lds_wg, int tid_in, int pair, bf16_t* z1, unsigned char* ws, bool st = true) {
    constexpr int QS = 272, SS = 144;
    constexpr int OFF_Q = 0, OFF_K = 64 * QS, OFF_KU = 2 * 64 * QS, OFF_SC = 3 * 64 * QS, OFF_VEC = OFF_SC + 64 * SS, UNIT_LDS = OFF_VEC + 512;
    int tid_ = tid_in; asm volatile("" : "+v"(tid_)); const int tid = tid_, lane = tid & 63, wid = __builtin_amdgcn_readfirstlane(tid >> 6), r = lane & 31, hh = lane >> 5;
    const int half = wid >> 2, w4 = wid & 3, t256 = tid & 255;
    const int ui = 2 * pair + half, b = ui >> 9, h = (ui >> 6) & 7, c = ui & 63;
    LAS unsigned char* lds = lds_wg + half * UNIT_LDS;
    LAS unsigned char* Qb = lds + OFF_Q; LAS unsigned char* Kb = lds + OFF_K; LAS unsigned char* KUb = lds + OFF_KU; LAS unsigned char* SCb = lds + OFF_SC;
    LAS float* A_ = (LAS float*)(lds + OFF_VEC); LAS float* R_ = A_ + 64;
    const size_t tok0 = (size_t)b * SEQL + c * 64; const int unit = (b * 8 + h) * 64 + c;
    const float* Ug = (const float*)(ws + GV_U);
    if (w4 == 0) { A_[lane] = ((const float*)(ws + GV_A))[(tok0 + lane) * 8 + h]; R_[lane] = ((const float*)(ws + GV_R))[(tok0 + lane) * 8 + h]; }
#pragma unroll
    for (int i = 0; i < 8; ++i) {
        const int row = (t256 >> 5) + 8 * i, cgi = t256 & 31, isk = cgi >> 4, c8 = (cgi & 15) * 8;
        bf16_t* gp = z1 + (tok0 + row) * Z1_LD + 1280 + isk * 1024 + h * 128 + c8;
        const u32x4 v = *(const u32x4*)gp;
        if (!isk) *(LAS u32x4*)(Qb + row * QS + c8 * 2) = v;
        else { *(LAS u32x4*)(Kb + row * QS + c8 * 2) = v; const float us = Ug[(tok0 + row) * 8 + h]; float f[8]; unpack8(v, f);
#pragma unroll
            for (int e = 0; e < 8; ++e) f[e] *= us;
            const u32x4 w = pack8(f); *(LAS u32x4*)(KUb + row * QS + c8 * 2) = w; if (st) *(u32x4*)gp = w; }
    }
    __syncthreads();
    if (w4 < 3) {
        const int tb = w4 >= 1, sb = w4 == 2;
        f32x16 sa;
#pragma unroll
        for (int i = 0; i < 16; ++i) sa[i] = 0.f;
#pragma unroll
        for (int ks = 0; ks < 8; ++ks) {
            const bf16x8 qa = *(const LAS bf16x8*)(Qb + (32 * tb + r) * QS + ks * 32 + hh * 16);
            const bf16x8 kb = *(const LAS bf16x8*)(Kb + (32 * sb + r) * QS + ks * 32 + hh * 16);
            sa = MFMA32(qa, kb, sa);
        }
        const int s = 32 * sb + r; const float as = A_[s];
#pragma unroll
        for (int i = 0; i < 16; ++i) {
            const int t = 32 * tb + (i & 3) + 8 * (i >> 2) + 4 * hh;
            const float w = (s <= t) ? __expf(as + R_[t]) : 0.f;
            *(LAS unsigned short*)(SCb + t * SS + s * 2) = (unsigned short)(pk2(sa[i] * w, 0.f) & 0xffffu);
            if (w4 == 0) *(LAS unsigned short*)(SCb + t * SS + (32 + r) * 2) = 0;
        }
    } else {
        float a0 = 0.f, a1 = 0.f;
#pragma unroll 8
        for (int s = 0; s < 64; ++s) { a0 += bf2f(*(const LAS unsigned short*)(KUb + s * QS + lane * 2)); a1 += bf2f(*(const LAS unsigned short*)(KUb + s * QS + (64 + lane) * 2)); }
        if (st) { ((float*)(ws + GV_DN))[(size_t)unit * 128 + lane] = a0; ((float*)(ws + GV_DN))[(size_t)unit * 128 + 64 + lane] = a1; } else asm volatile("" :: "v"(a0), "v"(a1));
    }
    __syncthreads();
#pragma unroll
    for (int j = 0; j < 2; ++j) { const int idx = t256 + 256 * j, row = idx >> 3, ch = idx & 7;
      const u32x4 o_ = *(const LAS u32x4*)(SCb + row * SS + ch * 16); if (st) *(u32x4*)((bf16_t*)(ws + WS_SC) + (size_t)unit * 4096 + row * 64 + ch * 8) = o_; else asm volatile("" :: "v"(o_)); }
    if (t256 < 64) { float d = 0.f;
#pragma unroll
        for (int k8 = 0; k8 < 8; ++k8) { float f[8]; unpack8(*(const LAS u32x4*)(SCb + t256 * SS + k8 * 16), f);
#pragma unroll
            for (int e = 0; e < 8; ++e) d += f[e]; }
        if (st) ((float*)(ws + GV_DI))[(tok0 + t256) * 8 + h] = d; else asm volatile("" :: "v"(d)); }
    __syncthreads();
}
__device__ __forceinline__ void mlstm_seq(LAS unsigned char* lds, int tid_in, int b, int h, const bf16_t* z1, const bf16_t* z2a, const float* g_hnorm, bf16_t* yb, const unsigned char* ws) {
    constexpr int QS = 272, US = 320, VS = 576, SS = 144;
    constexpr int OFF_Q = 0, OFF_KU = 64 * QS, OFF_V = OFF_KU + 64 * US, OFF_SC = OFF_V + 64 * VS, OFF_VEC = OFF_SC + 64 * SS;
    LAS unsigned char* Qb = lds + OFF_Q; LAS unsigned char* KUb = lds + OFF_KU; LAS unsigned char* Vb = lds + OFF_V; LAS unsigned char* SCb = lds + OFF_SC;
    LAS float* NV = (LAS float*)(lds + OFF_VEC); LAS float* INV = NV + 128; LAS float* PR = NV + 192; LAS float* GH = NV + 704;
    int tid_ = tid_in; asm volatile("" : "+v"(tid_)); const int tid = tid_, lane = tid & 63, wid = __builtin_amdgcn_readfirstlane(tid >> 6), r = lane & 31, hh = lane >> 5;
    const int g4 = lane >> 4, i16 = lane & 15, q4 = i16 >> 2, p4 = i16 & 3;
    const float* WIg = (const float*)(ws + GV_WI); const float* EIg = (const float*)(ws + GV_EI); const float* DIg = (const float*)(ws + GV_DI);
    const float* DECg = (const float*)(ws + GV_DEC) + (b * 8 + h) * 64; const float* DNg = (const float*)(ws + GV_DN) + (size_t)(b * 8 + h) * 64 * 128;
    const bf16_t* SCg = (const bf16_t*)(ws + WS_SC) + (size_t)(b * 8 + h) * 64 * 4096;
    f32x16 X[4];
#pragma unroll
    for (int d = 0; d < 4; ++d)
#pragma unroll
        for (int i = 0; i < 16; ++i) X[d][i] = 0.f;
    if (tid < 128) NV[tid] = 0.f;
    if (tid < 256) GH[tid] = g_hnorm[h * 256 + tid];
    u32x4 pq[2], pk[2], pv[4], psc; u32x2 pzo[2][4]; float pwi0, pwi1, pwq, peq, pdq, pdn = 0.f, pdec;
    const int srow = tid >> 4, sc16 = tid & 15;
    const int vrow = tid >> 5, vc = tid & 31;
    const int tq = tid >> 3, part = tid & 7;
#define ML_PREFETCH(cc) do { const size_t t0_ = (size_t)b * SEQL + (size_t)(cc) * 64; pdec = DECg[(cc)]; \
        _Pragma("unroll") for (int i = 0; i < 2; ++i) { const bf16_t* p_ = z1 + (t0_ + srow + 32 * i) * Z1_LD + 1280 + h * 128 + sc16 * 8; pq[i] = *(const u32x4*)p_; pk[i] = *(const u32x4*)(p_ + 1024); } \
        _Pragma("unroll") for (int i = 0; i < 4; ++i) pv[i] = *(const u32x4*)(z2a + (t0_ + vrow + 16 * i) * Z2_LD + h * 256 + vc * 8); \
        psc = *(const u32x4*)(SCg + (size_t)(cc) * 4096 + tid * 8); \
        _Pragma("unroll") for (int tb = 0; tb < 2; ++tb) _Pragma("unroll") for (int g = 0; g < 4; ++g) pzo[tb][g] = *(const u32x2*)(z2a + (t0_ + 32 * tb + r) * Z2_LD + 2048 + h * 256 + 32 * wid + 8 * g + 4 * hh); \
        pwi0 = WIg[(t0_ + r) * 8 + h]; pwi1 = WIg[(t0_ + 32 + r) * 8 + h]; pwq = WIg[(t0_ + tq) * 8 + h]; peq = EIg[(t0_ + tq) * 8 + h]; pdq = DIg[(t0_ + tq) * 8 + h]; \
        if (tid < 128) pdn = DNg[(size_t)(cc) * 128 + tid]; } while (0)
    ML_PREFETCH(0);
#pragma nounroll
    for (int c = 0; c < 64; ++c) {
        const size_t tok0 = (size_t)b * SEQL + c * 64;
        const float decay = pdec;
#pragma unroll
        for (int i = 0; i < 2; ++i) { *(LAS u32x4*)(Qb + (srow + 32 * i) * QS + sc16 * 16) = pq[i]; *(LAS u32x4*)(KUb + (srow + 32 * i) * US + sc16 * 16) = pk[i]; }
#pragma unroll
        for (int i = 0; i < 4; ++i) *(LAS u32x4*)(Vb + (vrow + 16 * i) * VS + vc * 16) = pv[i];
        *(LAS u32x4*)(SCb + (tid >> 3) * SS + (tid & 7) * 16) = psc;
        u32x2 zo[2][4];
#pragma unroll
        for (int tb = 0; tb < 2; ++tb)
#pragma unroll
            for (int g = 0; g < 4; ++g) zo[tb][g] = pzo[tb][g];
        const float wi0 = pwi0, wi1 = pwi1, wq = pwq, eq = peq, dq0 = pdq, dn = pdn;
        __syncthreads();
        if (c + 1 < 64) ML_PREFETCH(c + 1);
        f32x16 Z[2];
#pragma unroll
        for (int i = 0; i < 16; ++i) { Z[0][i] = 0.f; Z[1][i] = 0.f; }
#pragma unroll
        for (int dkb = 0; dkb < 4; ++dkb)
#pragma unroll
            for (int s2 = 0; s2 < 2; ++s2) {
                const bf16x8 ax = packacc8(X[dkb], 8 * s2);
#pragma unroll
                for (int tb = 0; tb < 2; ++tb) {
                    const LAS unsigned char* p = Qb + (32 * tb + r) * QS + (32 * dkb + 16 * s2 + 4 * hh) * 2;
                    const u32x2 lo = *(const LAS u32x2*)p, hi = *(const LAS u32x2*)(p + 16);
                    const u32x4 bq = {lo.x, lo.y, hi.x, hi.y};
                    Z[tb] = MFMA32(ax, __builtin_bit_cast(bf16x8, bq), Z[tb]);
                }
            }
#pragma unroll
        for (int i = 0; i < 16; ++i) { Z[0][i] *= wi0; Z[1][i] *= wi1; }
        { float f[16]; { float t8[8]; unpack8(*(const LAS u32x4*)(Qb + tq * QS + part * 32), t8);
#pragma unroll
              for (int e = 0; e < 8; ++e) f[e] = t8[e];
              unpack8(*(const LAS u32x4*)(Qb + tq * QS + part * 32 + 16), t8);
#pragma unroll
              for (int e = 0; e < 8; ++e) f[8 + e] = t8[e]; }
          float dq = 0.f;
#pragma unroll
          for (int j = 0; j < 4; ++j) { const f32x4 n4 = *(const LAS f32x4*)(NV + 16 * part + 4 * j); dq += (f[4 * j] * n4[0] + f[4 * j + 1] * n4[1]) + (f[4 * j + 2] * n4[2] + f[4 * j + 3] * n4[3]); }
          dq += __shfl_xor(dq, 1); dq += __shfl_xor(dq, 2); dq += __shfl_xor(dq, 4);
          if (part == 0) INV[tq] = 1.f / fmaxf(fabsf(wq * dq + dq0), eq); }
        bf16x8 vf[4];
#pragma unroll
        for (int ks = 0; ks < 4; ++ks) {
            const LAS unsigned char* p = Vb + (16 * ks + 8 * hh + q4) * VS + (32 * wid + 16 * (g4 & 1) + 4 * p4) * 2;
            vf[ks] = cat44(trread(p), trread(p + 4 * VS));
        }
#pragma unroll
        for (int tb = 0; tb < 2; ++tb)
#pragma unroll
            for (int ks = 0; ks < 4; ++ks) {
                const bf16x8 bs = *(const LAS bf16x8*)(SCb + (32 * tb + r) * SS + (16 * ks + 8 * hh) * 2);
                Z[tb] = MFMA32(vf[ks], bs, Z[tb]);
            }
        { float p0 = 0.f, p1 = 0.f;
#pragma unroll
          for (int i = 0; i < 16; ++i) { p0 += Z[0][i] * Z[0][i]; p1 += Z[1][i] * Z[1][i]; }
          p0 += __shfl_xor(p0, 32); p1 += __shfl_xor(p1, 32);
          if (hh == 0) { PR[r * 8 + wid] = p0; PR[(32 + r) * 8 + wid] = p1; } }
#pragma unroll
        for (int dkb = 0; dkb < 4; ++dkb) {
#pragma unroll
            for (int i = 0; i < 16; ++i) X[dkb][i] *= decay;
#pragma unroll
            for (int ks = 0; ks < 4; ++ks) {
                const LAS unsigned char* p = KUb + (16 * ks + 8 * hh + q4) * US + (32 * dkb + 16 * (g4 & 1) + 4 * p4) * 2;
                X[dkb] = MFMA32(cat44(trread(p), trread(p + 4 * US)), vf[ks], X[dkb]);
            }
        }
        LDS_WAIT(); __builtin_amdgcn_s_barrier(); asm volatile("" ::: "memory");
        if (tid < 128) NV[tid] = decay * NV[tid] + dn;
#pragma unroll
        for (int tb = 0; tb < 2; ++tb) {
            const int t = 32 * tb + r;
            const float inv = INV[t];
            const f32x4 pa = *(const LAS f32x4*)(PR + t * 8), pb = *(const LAS f32x4*)(PR + t * 8 + 4);
            const float rn = inv * rsqrtf(inv * inv * ((pa[0] + pa[1]) + (pa[2] + pa[3]) + (pb[0] + pb[1]) + (pb[2] + pb[3])) * (1.f / 256.f) + EPSN);
#pragma unroll
            for (int g = 0; g < 4; ++g) {
                const int dv = 32 * wid + 8 * g + 4 * hh;
                const f32x4 gh = *(const LAS f32x4*)(GH + dv);
                u32x2 w; w.x = pk2(Z[tb][4 * g] * rn * gh[0] * bflo(zo[tb][g].x), Z[tb][4 * g + 1] * rn * gh[1] * bfhi(zo[tb][g].x));
                w.y = pk2(Z[tb][4 * g + 2] * rn * gh[2] * bflo(zo[tb][g].y), Z[tb][4 * g + 3] * rn * gh[3] * bfhi(zo[tb][g].y));
                *(u32x2*)(yb + (tok0 + t) * Z2_LD + h * 256 + dv) = w;
            }
        }
    }
#undef ML_PREFETCH
}

__device__ __forceinline__ void qk_conv_item(int tid_in, int b, int strip, bf16_t* z1, const float* conv_qk) {
    int tid_ = tid_in; asm volatile("" : "+v"(tid_)); const int tid = tid_, lane = tid & 63, wid = __builtin_amdgcn_readfirstlane(tid >> 6), rl = lane >> 3, cg = lane & 7;
    const int ch = 64 * strip + 8 * cg;
    float w[4][8];
#pragma unroll
    for (int j = 0; j < 4; ++j) { const f32x4 a = *(const f32x4*)(conv_qk + j * 2048 + ch), c = *(const f32x4*)(conv_qk + j * 2048 + ch + 4);
#pragma unroll
        for (int e = 0; e < 4; ++e) { w[j][e] = a[e]; w[j][4 + e] = c[e]; } }
    const float qs = (ch < 1024) ? 0.08838834764831845f : 1.f;
    bf16_t* base = z1 + ((size_t)b * SEQL + 512 * wid) * Z1_LD + 1280 + ch;
    u32x4 prev = {0u, 0u, 0u, 0u};
    if (wid > 0) prev = *(const u32x4*)(base + (ptrdiff_t)(rl - 8) * Z1_LD);
    asm volatile("s_waitcnt vmcnt(0)" ::: "memory");
    __syncthreads();
    u32x4 cur4[4];
#pragma unroll
    for (int j = 0; j < 4; ++j) cur4[j] = *(const u32x4*)(base + (size_t)(8 * j + rl) * Z1_LD);
    u32x4 nxt4[4];
#pragma unroll
    for (int j = 0; j < 4; ++j) nxt4[j] = *(const u32x4*)(base + (size_t)(32 + 8 * j + rl) * Z1_LD);
#pragma nounroll
    for (int blk = 0; blk < 16; ++blk) {
        u32x4 nn4[4];
        if (blk + 2 < 16) {
#pragma unroll
            for (int j = 0; j < 4; ++j) nn4[j] = *(const u32x4*)(base + (size_t)(32 * (blk + 2) + 8 * j + rl) * Z1_LD);
        }
#pragma unroll
        for (int j = 0; j < 4; ++j) {
            bf16_t* p = base + (size_t)(32 * blk + 8 * j + rl) * Z1_LD;
            const u32x4 cur = cur4[j];
            float x[8], y[8]; unpack8(cur, x);
#pragma unroll
            for (int e = 0; e < 8; ++e) y[e] = w[3][e] * x[e];
#pragma unroll
            for (int d = 1; d <= 3; ++d) {
                const u32x4 snd = (rl + d <= 7) ? cur : prev; const int src = (lane + 64 - 8 * d) & 63;
                u32x4 g; g.x = __shfl(snd.x, src); g.y = __shfl(snd.y, src); g.z = __shfl(snd.z, src); g.w = __shfl(snd.w, src);
                float xd[8]; unpack8(g, xd);
#pragma unroll
                for (int e = 0; e < 8; ++e) y[e] += w[3 - d][e] * xd[e];
            }
#pragma unroll
            for (int e = 0; e < 8; ++e) y[e] = y[e] * sigm(y[e]) * qs;
            *(u32x4*)p = pack8(y);
            prev = cur;
        }
#pragma unroll
        for (int j = 0; j < 4; ++j) { cur4[j] = nxt4[j]; nxt4[j] = nn4[j]; }
    }
}
__device__ __forceinline__ void ffn_conv_item(int tid_in, int b, int strip, bf16_t* h1, const bf16_t* h2, const float* cw, const float* cb, bool st = true) {
    int tid_ = tid_in; asm volatile("" : "+v"(tid_)); const int tid = tid_, lane = tid & 63, wid = __builtin_amdgcn_readfirstlane(tid >> 6), rl = lane >> 3, cg = lane & 7;
    const int ch = 64 * strip + 8 * cg;
    float wg[3][8], wv[3][8], bg[8], bv[8];
#pragma unroll
    for (int j = 0; j < 3; ++j) { const f32x4 a = *(const f32x4*)(cw + j * 11264 + ch), c = *(const f32x4*)(cw + j * 11264 + ch + 4), a2 = *(const f32x4*)(cw + j * 11264 + 5632 + ch), c2 = *(const f32x4*)(cw + j * 11264 + 5632 + ch + 4);
#pragma unroll
        for (int e = 0; e < 4; ++e) { wg[j][e] = a[e]; wg[j][4 + e] = c[e]; wv[j][e] = a2[e]; wv[j][4 + e] = c2[e]; } }
    { const f32x4 a = *(const f32x4*)(cb + ch), c = *(const f32x4*)(cb + ch + 4), a2 = *(const f32x4*)(cb + 5632 + ch), c2 = *(const f32x4*)(cb + 5632 + ch + 4);
#pragma unroll
      for (int e = 0; e < 4; ++e) { bg[e] = a[e]; bg[4 + e] = c[e]; bv[e] = a2[e]; bv[4 + e] = c2[e]; } }
    const size_t off0 = ((size_t)b * SEQL + 512 * wid) * 5632 + ch;
    u32x4 pg = {0u, 0u, 0u, 0u}, pv = {0u, 0u, 0u, 0u};
    if (wid > 0) { pg = *(const u32x4*)(h1 + off0 + (ptrdiff_t)(rl - 8) * 5632); pv = *(const u32x4*)(h2 + off0 + (ptrdiff_t)(rl - 8) * 5632); }
    asm volatile("s_waitcnt vmcnt(0)" ::: "memory");
    __syncthreads();
    u32x4 cg4[4], cv4[4];
#pragma unroll
    for (int j = 0; j < 4; ++j) { cg4[j] = __builtin_nontemporal_load((const u32x4*)(h1 + off0 + (size_t)(8 * j + rl) * 5632)); cv4[j] = __builtin_nontemporal_load((const u32x4*)(h2 + off0 + (size_t)(8 * j + rl) * 5632)); }
    u32x4 ng4[4], nv4[4];
#pragma unroll
    for (int j = 0; j < 4; ++j) { const size_t o_ = off0 + (size_t)(32 + 8 * j + rl) * 5632; ng4[j] = __builtin_nontemporal_load((const u32x4*)(h1 + o_)); nv4[j] = __builtin_nontemporal_load((const u32x4*)(h2 + o_)); }
#pragma nounroll
    for (int blk = 0; blk < 16; ++blk) {
        u32x4 mg4[4], mv4[4];
        if (blk + 2 < 16) {
#pragma unroll
            for (int j = 0; j < 4; ++j) { const size_t o_ = off0 + (size_t)(32 * (blk + 2) + 8 * j + rl) * 5632; mg4[j] = __builtin_nontemporal_load((const u32x4*)(h1 + o_)); mv4[j] = __builtin_nontemporal_load((const u32x4*)(h2 + o_)); }
        }
#pragma unroll
        for (int j = 0; j < 4; ++j) {
            const size_t off = off0 + (size_t)(32 * blk + 8 * j + rl) * 5632;
            const u32x4 cgv = cg4[j], cvv = cv4[j];
            float xg[8], xv[8], yg[8], yv[8]; unpack8(cgv, xg); unpack8(cvv, xv);
#pragma unroll
            for (int e = 0; e < 8; ++e) { yg[e] = bg[e] + wg[2][e] * xg[e]; yv[e] = bv[e] + wv[2][e] * xv[e]; }
#pragma unroll
            for (int d = 1; d <= 2; ++d) {
                const bool own = (rl + d <= 7); const int src = (lane + 64 - 8 * d) & 63;
                const u32x4 sg = own ? cgv : pg, sv = own ? cvv : pv;
                u32x4 g, v; g.x = __shfl(sg.x, src); g.y = __shfl(sg.y, src); g.z = __shfl(sg.z, src); g.w = __shfl(sg.w, src);
                v.x = __shfl(sv.x, src); v.y = __shfl(sv.y, src); v.z = __shfl(sv.z, src); v.w = __shfl(sv.w, src);
                float dg[8], dv[8]; unpack8(g, dg); unpack8(v, dv);
#pragma unroll
                for (int e = 0; e < 8; ++e) { yg[e] += wg[2 - d][e] * dg[e]; yv[e] += wv[2 - d][e] * dv[e]; }
            }
#pragma unroll
            for (int e = 0; e < 8; ++e) yg[e] = yg[e] * sigm(yg[e]) * yv[e];
            { const u32x4 o_ = pack8(yg); if (st) *(u32x4*)(h1 + off) = o_; else asm volatile("" :: "v"(o_)); }
            pg = cgv; pv = cvv;
        }
#pragma unroll
        for (int j = 0; j < 4; ++j) { cg4[j] = ng4[j]; cv4[j] = nv4[j]; ng4[j] = mg4[j]; nv4[j] = mv4[j]; }
    }
}
__device__ __forceinline__ void tr_item(const float* W, int N, int scol0, int valid, const float* gain, bf16_t* WT, int K, int drow0, LAS float* scr, int kb, int lane) {
    const int k0 = 64 * kb, rr = lane >> 3, c4 = (lane & 7) * 4;
    f32x4 tv[8];
#pragma unroll
    for (int i = 0; i < 8; ++i) tv[i] = (c4 < valid) ? __builtin_nontemporal_load((const f32x4*)(W + (size_t)(k0 + 8 * i + rr) * N + scol0 + c4)) : (f32x4){0.f, 0.f, 0.f, 0.f};
#pragma unroll
    for (int i = 0; i < 8; ++i) { const int kk = 8 * i + rr; const float g = gain ? gain[k0 + kk] : 1.f;
        scr[kk * 33 + c4] = tv[i][0] * g; scr[kk * 33 + c4 + 1] = tv[i][1] * g; scr[kk * 33 + c4 + 2] = tv[i][2] * g; scr[kk * 33 + c4 + 3] = tv[i][3] * g; }
    LDS_WAIT(); asm volatile("" ::: "memory");
    const int c = lane & 7;
#pragma unroll
    for (int j = 0; j < 4; ++j) { const int nn = (lane >> 3) + 8 * j; const LAS float* s = scr + (8 * c) * 33 + nn;
        u32x4 o; o.x = pk2(s[0 * 33], s[1 * 33]); o.y = pk2(s[2 * 33], s[3 * 33]); o.z = pk2(s[4 * 33], s[5 * 33]); o.w = pk2(s[6 * 33], s[7 * 33]);
        *(u32x4*)(WT + (size_t)(drow0 + nn) * K + k0 + 8 * c) = o; }
    LDS_WAIT(); asm volatile("" ::: "memory");
}
__device__ const float INVF[32] = {1.000000000e+00f, 7.498942018e-01f, 5.623413324e-01f, 4.216965139e-01f, 3.162277639e-01f, 2.371373773e-01f, 1.778279394e-01f, 1.333521456e-01f, 1.000000015e-01f, 7.498942316e-02f, 5.623413250e-02f, 4.216964915e-02f, 3.162277490e-02f, 2.371373773e-02f, 1.778279431e-02f, 1.333521400e-02f, 9.999999776e-03f, 7.498942316e-03f, 5.623413250e-03f, 4.216964822e-03f, 3.162277630e-03f, 2.371373819e-03f, 1.778279431e-03f, 1.333521446e-03f, 1.000000047e-03f, 7.498941850e-04f, 5.623413017e-04f, 4.216965172e-04f, 3.162277571e-04f, 2.371373703e-04f, 1.778279402e-04f, 1.333521504e-04f};
__device__ __forceinline__ void tr_mat_item(ArgsP a, int mat, int item, LAS float* scr, int lane) {
    const float* src; const float* gain = nullptr; int K, N, nblk; size_t dst;
    int nb0 = 0;
    switch (mat) {
        case 0: src = a->in[4]; K = 2048; N = 11344; nblk = 360; dst = WS_WIN_T; break;
        case 12: src = a->in[4]; K = 2048; N = 11344; nblk = 104; dst = WS_WIN_T; mat = 0; break;
        case 13: src = a->in[4]; K = 2048; N = 11344; nblk = 256; nb0 = 104; dst = WS_WIN_T; mat = 0; break;
        case 1: src = a->in[6]; K = 512; N = 3072; nblk = 96; dst = WS_WQB_T; gain = a->in[5]; break;
        case 2: src = a->in[8]; K = 512; N = 4096; nblk = 128; dst = WS_WKVB_T; gain = a->in[7]; break;
        case 3: src = a->in[16]; K = 2048; N = 2048; nblk = 64; dst = WS_PA_T; break;
        case 4: src = a->in[17]; K = 2048; N = 2048; nblk = 64; dst = WS_PB_T; break;
        case 5: src = a->in[18]; K = 2048; N = 2048; nblk = 64; dst = WS_WOUT_T; break;
        case 6: src = a->in[21]; K = 2048; N = 512; nblk = 16; dst = WS_WQC_T; gain = a->in[19]; break;
        case 7: src = a->in[22]; K = 2048; N = 512; nblk = 16; dst = WS_WKC_T; break;
        case 8: src = a->in[23]; K = 2048; N = 512; nblk = 16; dst = WS_WVC_T; break;
        case 9: src = a->in[26]; K = 512; N = 2048; nblk = 64; dst = WS_WOC_T; break;
        case 10: src = a->in[28]; K = 2048; N = 11264; nblk = 352; dst = WS_WUP_T; gain = a->in[27]; break;
        default: src = a->in[31]; K = 5632; N = 2048; nblk = 64; dst = WS_WDN_T; break;
    }
    const int kb = item / nblk, nb = item % nblk + nb0;
    int scol = 32 * nb, drow = 32 * nb, valid = 32;
    if (mat == 0) {
        if (drow < 1088) scol = drow; else if (drow == 1088) { scol = 5184; valid = 16; } else if (drow < 1280) { scol = 0; valid = 0; } else if (drow < 5376) scol = drow - 192; else scol = drow - 176;
    } else if (mat == 1) {
        const int hq = scol / 192, w = scol % 192;
        if (w < 128) drow = 128 * hq + w; else drow = 2048 + 256 * (hq >> 2) + 128 * ((w - 128) >> 5) + 32 * (hq & 3);
    } else if (mat == 2) {
        const int hk = scol / 256, w = scol % 256;
        drow = (w < 128) ? 128 * hk + w : 2048 + 128 * hk + (w - 128);
    }
    if (mat == 0 && drow >= 7424) { dst = WS_WING; drow -= 7424; }
    tr_item(src, N, scol, valid, gain, (bf16_t*)(a->ws + dst), K, drow, scr, kb, lane);
}
__device__ __forceinline__ void norm_row(const float* xr, const float* g, bf16_t* orow, int lane) {
    f32x4 v[8]; float s = 0.f;
#pragma unroll
    for (int j = 0; j < 8; ++j) { v[j] = __builtin_nontemporal_load((const f32x4*)(xr + 4 * lane + 256 * j)); s += (v[j][0] * v[j][0] + v[j][1] * v[j][1]) + (v[j][2] * v[j][2] + v[j][3] * v[j][3]); }
    const float rs = rsqrtf(wave_sum(s) * (1.f / 2048.f) + EPSN);
#pragma unroll
    for (int j = 0; j < 8; ++j) { const f32x4 gg = *(const f32x4*)(g + 4 * lane + 256 * j); u32x2 w; w.x = pk2(v[j][0] * rs * gg[0], v[j][1] * rs * gg[1]); w.y = pk2(v[j][2] * rs * gg[2], v[j][3] * rs * gg[3]);
        *(u32x2*)(orow + 4 * lane + 256 * j) = w; }
}

__global__ void __launch_bounds__(512, 2) mk_fwd(Args a_) {
    extern __shared__ __attribute__((aligned(16))) unsigned char lds_raw[];
    LAS unsigned char* lds = (LAS unsigned char*)lds_raw;
    cg::grid_group grid = cg::this_grid();
    const int ph_lo = a_.ph_lo, ph_hi = a_.ph_hi;
    if (threadIdx.x < 2) ((volatile LAS unsigned*)(lds + LDS_MISC))[threadIdx.x] = 0u;
    __syncthreads();
    const XcdBarrier xbar = xcd_barrier_post((unsigned*)(a_.ws + WS_BAR), (volatile LAS unsigned*)(lds + LDS_MISC));
    const int wid0 = __builtin_amdgcn_readfirstlane((int)threadIdx.x >> 6);
    for (int ph = ph_lo; ph < ph_hi; ++ph) {
        ArgsP a = (ArgsP)__builtin_amdgcn_kernarg_segment_ptr(); asm volatile("" : "+s"(a));
        int bid_ = blockIdx.x; asm volatile("" : "+s"(bid_));
        const int G = gridDim.x, bid = bid_;
#define MK_TID() ({ int w_ = wid0, z_ = 0; asm volatile("" : "+s"(w_), "+s"(z_)); w_ * 64 + (int)__builtin_amdgcn_mbcnt_hi(~0u, __builtin_amdgcn_mbcnt_lo(~0u, (unsigned)z_)); })
        unsigned char* ws = a->ws; unsigned char* ob = (unsigned char*)a->out;
        float* ssq_qa = (float*)(ws + WS_SSQ_QA); float* ssq_kv = (float*)(ws + WS_SSQ_KV); float* ssq_x1 = (float*)(ws + WS_SSQ_X1); float* ssq_x2 = (float*)(ws + WS_SSQ_X2);
        float* ropec = (float*)(ws + WS_ROPE); float* ropes = ropec + (size_t)MT * 32;
        bf16_t* z1 = (bf16_t*)(ws + WS_Z1); bf16_t* ub = (bf16_t*)(ws + WS_U); bf16_t* z2a = (bf16_t*)(ws + WS_Z2A); bf16_t* z2b = (bf16_t*)(ob + O_Z2B);
        bf16_t* qn = (bf16_t*)(ob + O_QN); bf16_t* qpe = (bf16_t*)(ob + O_QPE); bf16_t* kn = (bf16_t*)(ws + WS_KN); bf16_t* vb = (bf16_t*)(ws + WS_V); bf16_t* kpe = (bf16_t*)(ws + WS_KPE);
        bf16_t* ya = (bf16_t*)(ws + WS_YA); bf16_t* ta = (bf16_t*)(ws + WS_TA); bf16_t* x1b = (bf16_t*)(ws + WS_X1B); bf16_t* x2b = (bf16_t*)(ws + WS_X2B);
        bf16_t* memn = (bf16_t*)(ws + WS_MEMN); bf16_t* qc = (bf16_t*)(ws + WS_QC); bf16_t* kc = (bf16_t*)(ws + WS_KC); bf16_t* vc = (bf16_t*)(ws + WS_VC); bf16_t* oc = (bf16_t*)(ws + WS_OC);
        bf16_t* h1 = (bf16_t*)(ws + WS_H1); bf16_t* h2 = (bf16_t*)(ws + WS_H2);


#ifndef MK_DUP
#define MK_DUP (-1)
#endif
#ifndef MK_DUPS
#define MK_DUPS (-1)
#endif
        for (int rep = 0; rep < (((MK_DUP >= 0 && ph == MK_DUP) || (MK_DUPS >= 0 && ph == MK_DUPS)) ? 2 : 1); ++rep) {
        if (ph == 0) {
            const int tid = MK_TID(), lane = tid & 63, wid = __builtin_amdgcn_readfirstlane(tid >> 6), gw = bid * 8 + wid, NGW = G * 8;
            for (int i = bid * 512 + tid; i < 4 * MT;) { ((float*)(ws + WS_SSQ_QA))[i] = 0.f; i += G * 512; asm volatile("" : "+v"(i)); }
            const int* pos = (const int*)a->in[2];
            for (int i = bid * 512 + tid; i < MT * 32;) {
                const float ang = (float)pos[i >> 5] * INVF[i & 31];
                double rd = (double)ang; rd -= rint(rd * 0.15915494309189535) * 6.283185307179586;
                const float rf = (float)rd; ropec[i] = __cosf(rf); ropes[i] = __sinf(rf);
                i += G * 512; asm volatile("" : "+v"(i));
            }
            LAS float* scr = (LAS float*)(lds + wid * 16384);
#pragma nounroll
            for (int it = gw; it < 3328 + 1792; it += NGW) {
                if (it < 3328) tr_mat_item(a, 12, it, scr, lane); else if (it < 3328 + 768) tr_mat_item(a, 1, it - 3328, scr, lane); else tr_mat_item(a, 2, it - 4096, scr, lane);
            }
#pragma unroll 2
            for (int m = gw; m < MT; m += NGW) norm_row(a->in[0] + (size_t)m * 2048, a->in[3], ub + (size_t)m * 2048, lane);
#pragma nounroll
            for (int m = gw; m < 1024; m += NGW) norm_row(a->in[1] + (size_t)m * 2048, a->in[20], memn + (size_t)m * 2048, lane);
        } else if (ph == 3) {
            const int tid = MK_TID(), wid = __builtin_amdgcn_readfirstlane(tid >> 6);
            for (int ui = bid; ui < 1024 && !(MK_DUPS == 3 && rep == 1); ui += G) {
                const int rnd = ui >> 8, c0 = ui & 255, xcd = c0 & 7, w = c0 >> 3;
                const int bh = 8 * xcd + 2 * rnd + (w >> 4), b = bh >> 4, h = bh & 15, qb = (rnd & 1) ? 15 - (w & 15) : (w & 15);
                const size_t row0 = (size_t)b * SEQL + qb * 256, kr0 = (size_t)b * SEQL;
                attn_unit<12>(lds, tid, qn + row0 * 2048 + h * 128, 2048, qpe + row0 * 1024 + h * 64, 1024, kn + kr0 * 2048 + h * 128, 2048, kpe + kr0 * 64, 64,
                              vb + kr0 * 2048 + h * 128, 2048, ya + row0 * 2048 + h * 128, 2048, 4 * qb + 4, 4 * qb + (wid >> 1) + 1, 0.07216878364870322f * 1.4426950408889634f);
            }
            for (int ui = bid; ui < 1024; ui += G) mlstm_pre_unit(lds, tid, ui, z1, ws, MK_DUPS != 3 || rep == 1);
            if (MK_DUPS == 3 && rep == 0) continue;
        } else if (ph == 5) {
            const int tid = MK_TID();
            if (rep > 0) {} else if (G > 2 * NML) { if (bid < NML) mlstm_seq(lds, tid, bid >> 3, bid & 7, z1, z2a, a->in[15], z2a, ws); }
            else for (int ui = bid; ui < 32; ui += G) mlstm_seq(lds, tid, ui >> 3, ui & 7, z1, z2a, a->in[15], z2a, ws);
        } else if (ph == 9) {
            const int tid = MK_TID();
            for (int ui = bid; ui < 256; ui += G) {
                const int b = ui >> 6, hc = (ui >> 4) & 3, qb = ui & 15;
                const size_t row0 = (size_t)b * SEQL + qb * 256, kr0 = (size_t)b * 256;
                attn_unit<8, true>(lds, tid, qc + row0 * 512 + hc * 128, 512, nullptr, 0, kc + kr0 * 512 + hc * 128, 512, nullptr, 0, vc + kr0 * 512 + hc * 128, 512, oc + row0 * 512 + hc * 128, 512, 4, 4,
                             0.08838834764831845f * 1.4426950408889634f);
            }
        } else if (ph == 12) {
            const int tid = MK_TID();
            for (int ui = bid; ui < 4 * 88; ui += G) { ffn_conv_item(tid, ui / 88, ui % 88, h1, h2, a->in[29], a->in[30], MK_DUPS != 12 || rep == 1); __syncthreads(); }
        }
        const int nbf = (ph == 1 || ph == 4 || ph == 5 || ph == 11) ? 1 : (ph == 2 || ph == 6) ? 2 : (ph == 8) ? 3 : 0;
        for (int gi = 0; gi < nbf; ++gi) {
            pg8::Gemm g; g.M = MT; g.K = 2048; g.lda = 2048; g.N = 2048; g.A = ub; g.Bt = nullptr;
            EpiBF E; E.mode = EM_Z1; E.a0 = a; E.P = (LAS float*)(lds + LDS_EPI);
            int cshift = 0;
            if (ph == 1) { g.Bt = (const bf16_t*)(ws + WS_WIN_T); g.N = 3328; E.mode = EM_Z1; }
            else if (ph == 2 && gi == 0) { g.A = z1; g.lda = Z1_LD; g.K = 512; g.Bt = (const bf16_t*)(ws + WS_WQB_T); g.N = 3072; E.mode = EM_Q; }
            else if (ph == 2) { g.A = z1 + 512; g.lda = Z1_LD; g.K = 512; g.Bt = (const bf16_t*)(ws + WS_WKVB_T); g.N = 4096; E.mode = EM_KV; }
            else if (ph == 4) { g.Bt = (const bf16_t*)(ws + WS_WIN_T) + (size_t)3328 * 2048; g.N = 4096; E.mode = EM_Z2; }
            else if (ph == 5) { g.Bt = (const bf16_t*)(ws + WS_WING); g.N = 4096; E.mode = EM_ZG; }
            else if (ph == 6 && gi == 0) { g.A = ya; g.Bt = (const bf16_t*)(ws + WS_PA_T); E.mode = EM_GA; }
            else if (ph == 6) { g.A = z2a; g.lda = Z2_LD; g.Bt = (const bf16_t*)(ws + WS_PB_T); E.mode = EM_GB; }
            else if (ph == 8 && gi == 0) { g.A = x1b; g.Bt = (const bf16_t*)(ws + WS_WQC_T); g.N = 512; E.mode = EM_QC; }
            else if (ph == 8 && gi == 1) { g.A = memn; g.M = 1024; g.Bt = (const bf16_t*)(ws + WS_WKC_T); g.N = 512; E.mode = EM_KC; cshift = 128; }
            else if (ph == 8) { g.A = memn; g.M = 1024; g.Bt = (const bf16_t*)(ws + WS_WVC_T); g.N = 512; E.mode = EM_VC; cshift = 136; }
            else { g.A = x2b; g.Bt = (const bf16_t*)(ws + WS_WUP_T); g.N = 11264; E.mode = EM_UP; }
            int cc_ = bid - cshift, Gg = G; if (cc_ < 0) cc_ += G; if (cc_ < 0) cc_ = bid;
            if (ph == 5 && G > 2 * NML) { if (bid < NML) continue; Gg = G - NML; cc_ = bid - NML; }
            pg8::StaticOrder S; S.init(g.M, g.N, Gg, cc_);
            pg8::gemm_phase<EpiBF, pg8::StaticOrder, true, true>(lds, MK_TID(), g, S, E);
        }
        }
        if (ph == 7 || ph == 10 || ph == 13) {
            pg8::Gemm g; g.M = MT; g.N = 2048; EpiF32 E; E.a0 = a;
            if (ph == 7) { g.A = ta; g.lda = 2048; g.K = 2048; g.Bt = (const bf16_t*)(ws + WS_WOUT_T); E.mode = 0; }
            else if (ph == 10) { g.A = oc; g.lda = 512; g.K = 512; g.Bt = (const bf16_t*)(ws + WS_WOC_T); E.mode = 1; }
            else { g.A = h1; g.lda = 5632; g.K = 5632; g.Bt = (const bf16_t*)(ws + WS_WDN_T); E.mode = 2; }
            pg8::StaticOrder S; S.init(g.M, g.N, G, bid);
            pg8::gemm_phase<EpiF32, pg8::StaticOrder, true, true>(lds, MK_TID(), g, S, E);
        }
        if (ph == 1) {
            const int tid = MK_TID(), lane = tid & 63, wid = __builtin_amdgcn_readfirstlane(tid >> 6);
            LAS float* scr = (LAS float*)(lds + wid * 16384);
            const int first = (G >= 128) ? 64 : 0, nw = (G - first) * 8;
            if (bid >= first) {
#pragma nounroll
                for (int it = (bid - first) * 8 + wid; it < 8192; it += nw) {
                    int r = it, mat;
                    if (r < 2048) mat = 3; else if ((r -= 2048) < 2048) mat = 4; else if ((r -= 2048) < 2048) mat = 5; else if ((r -= 2048) < 512) mat = 6; else if ((r -= 512) < 512) mat = 7; else if ((r -= 512) < 512) mat = 8; else { r -= 512; mat = 9; }
                    tr_mat_item(a, mat, r, scr, lane);
                }
            }
        } else if (ph == 2) {
            const int tid = MK_TID(), lane = tid & 63, wid = __builtin_amdgcn_readfirstlane(tid >> 6), gw = bid * 8 + wid, NGW = G * 8;
            const float* gk = a->in[12];
#pragma unroll 4
            for (int m = gw; m < MT; m += NGW) {
                const int l = lane & 31;
                const float x1 = bf2f(z1[(size_t)m * Z1_LD + 1024 + l]), x2 = bf2f(z1[(size_t)m * Z1_LD + 1056 + l]);
                const float s = wave_sum(lane < 32 ? x1 * x1 + x2 * x2 : 0.f);
                const float rn = rsqrtf(s * (1.f / 64.f) + EPSN);
                const float a1 = x1 * rn * gk[l], a2 = x2 * rn * gk[32 + l], cc = ropec[(size_t)m * 32 + l], ss = ropes[(size_t)m * 32 + l];
                if (lane < 32) { kpe[(size_t)m * 64 + l] = (bf16_t)(pk2(a1 * cc - a2 * ss, 0.f) & 0xffffu); kpe[(size_t)m * 64 + 32 + l] = (bf16_t)(pk2(a2 * cc + a1 * ss, 0.f) & 0xffffu); }
            }
            if (G >= 160) { if (bid >= 128 && bid < 160) gate_scan(lds, tid, (bid - 128) >> 3, bid & 7, z1, a->in[14], ws); }
            else for (int ui = bid; ui < 32; ui += G) gate_scan(lds, tid, ui >> 3, ui & 7, z1, a->in[14], ws);
            for (int ui = bid; ui < 4 * 32; ui += G) { qk_conv_item(tid, ui >> 5, ui & 31, z1, a->in[13]); __syncthreads(); }
            if (G >= 200) { if (bid >= 132) {
                LAS float* scr = (LAS float*)(lds + wid * 16384);
#pragma nounroll
                for (int it = (bid - 132) * 8 + wid; it < 8192; it += (G - 132) * 8) tr_mat_item(a, 13, it, scr, lane); } }
            else { LAS float* scr = (LAS float*)(lds + wid * 16384);
#pragma nounroll
                for (int it = gw; it < 8192; it += NGW) tr_mat_item(a, 13, it, scr, lane); }
        } else if (ph == 8) {
            const int tid = MK_TID(), lane = tid & 63, wid = __builtin_amdgcn_readfirstlane(tid >> 6), gw = bid * 8 + wid, NGW = G * 8;
            LAS float* scr = (LAS float*)(lds + wid * 16384);
#pragma nounroll
            for (int it = gw; it < 5632; it += NGW) tr_mat_item(a, 11, it, scr, lane);
        } else if (ph == 5) {
            const int tid = MK_TID(), lane = tid & 63, wid = __builtin_amdgcn_readfirstlane(tid >> 6);
            LAS float* scr = (LAS float*)(lds + wid * 16384);
            if (G > 2 * NML) { if (bid >= NML) {
#pragma nounroll
                for (int it = (bid - NML) * 8 + wid; it < 11264; it += (G - NML) * 8) tr_mat_item(a, 10, it, scr, lane); } }
            else {
#pragma nounroll
                for (int it = bid * 8 + wid; it < 11264; it += G * 8) tr_mat_item(a, 10, it, scr, lane); }
        }
        if (ph + 1 < ph_hi) { if (ph >= 1000) grid.sync(); else xcd_barrier(xbar); }
    }
}

extern "C" void kernel_launch(void* const* d_in, const int* in_sizes, int n_in, void* d_out, int out_size, void* d_ws, size_t ws_size, hipStream_t stream) {
    static int grid = 0;
    if (grid == 0) {
        if (n_in != 32 || in_sizes[0] != MT * 2048 || out_size != MT * 2048 || ws_size < WS_NEED) { fprintf(stderr, "kernel_launch: unexpected shapes / workspace (n_in %d, ws %zu)\n", n_in, ws_size); grid = -1; return; }
        int dev = 0, cus = 0, per_cu = 0;
        (void)hipGetDevice(&dev); (void)hipDeviceGetAttribute(&cus, hipDeviceAttributeMultiprocessorCount, dev);
        if (hipFuncSetAttribute((const void*)mk_fwd, hipFuncAttributeMaxDynamicSharedMemorySize, LDS_BYTES) != hipSuccess) { fprintf(stderr, "kernel_launch: hipFuncSetAttribute failed\n"); grid = -1; return; }
        if (hipOccupancyMaxActiveBlocksPerMultiprocessor(&per_cu, (const void*)mk_fwd, 512, LDS_BYTES) != hipSuccess || per_cu < 1) { fprintf(stderr, "kernel_launch: occupancy query says %d blocks per CU\n", per_cu); per_cu = 1; }
        (void)hipGetLastError();
        grid = cus > 0 ? cus : 256;
    }
    if (grid < 0) return;
    if (hipMemsetAsync((char*)d_ws + WS_BAR, 0, BAR_BYTES, stream) != hipSuccess) { fprintf(stderr, "kernel_launch: memset of the barrier words failed\n"); return; }
    Args a{};
    for (int i = 0; i < 32; ++i) a.in[i] = (const float*)d_in[i];
    a.out = (float*)d_out; a.ws = (unsigned char*)d_ws;
#ifndef MK_MULTI
    a.ph_lo = 0; a.ph_hi = NPHASE;
    void* args[] = {&a};
    hipError_t e = hipLaunchCooperativeKernel((const void*)mk_fwd, dim3(grid), dim3(512), args, LDS_BYTES, stream);
    if (e != hipSuccess) fprintf(stderr, "kernel_launch: cooperative launch failed: %s (grid %d)\n", hipGetErrorString(e), grid);
#else
    for (int p = 0; p < NPHASE; ++p) { a.ph_lo = p; a.ph_hi = p + 1; hipLaunchKernelGGL(mk_fwd, dim3(grid), dim3(512), LDS_BYTES, stream, a); }
#endif
}
```

```cpp
#include <hip/hip_runtime.h>
#include <hip/hip_cooperative_groups.h>
#include <cstdio>
#include <cstdint>
#include <cmath>
namespace cg = cooperative_groups;
namespace pg8 {
#define PG8_LAS __attribute__((address_space(3)))
typedef unsigned short bf16_t;
typedef short bf16x8 __attribute__((ext_vector_type(8)));
typedef float f32x4 __attribute__((ext_vector_type(4)));
typedef unsigned u32x4 __attribute__((ext_vector_type(4)));
constexpr int BM = 256, BK = 64, HALF = 128, HTB = HALF * BK * 2  , STAGE_BYTES = 8 * HTB, NXCD = 8, WGM = 8;

__host__ __device__ __forceinline__ int lds_byte(int r, int c) { const int st = (r >> 4) * 2 + (c >> 5), rr = r & 15, cc = c & 31, ob = rr * 64 + cc * 2; return st * 1024 + (ob ^ (((ob >> 9) & 1) << 5)); }
__host__ __device__ __forceinline__ void stage_rc(int b, int& R, int& C) { const int st = b / 1024, sb = b % 1024, swz = sb ^ (((sb >> 9) & 1) << 5); R = (st >> 1) * 16 + swz / 64; C = (st & 1) * 32 + (swz % 64) / 2; }
__host__ __device__ __forceinline__ int perm32(int rho) { const int n = rho >> 4, i = rho & 15; return 8 * (i >> 2) + 4 * n + (i & 3); }

struct Unit { int pm, pn; };
struct Gemm { const bf16_t* A; const bf16_t* Bt; int M, N, K, lda; };

struct StaticOrder {
    int nM, nN, nwg, G, c;
    __host__ __device__ void init(int M, int N, int G_, int c_) { nM = M / BM; nN = N / BM; nwg = nM * nN; G = G_; c = c_; }
    __host__ __device__ bool next(int i, Unit& u) const {
        const long L = (long)i * G + c; if (L >= nwg) return false;
        int wgid = (int)L; { const int q = nwg / NXCD, r = nwg % NXCD, xcd = wgid % NXCD, off = wgid / NXCD; wgid = (xcd < r ? xcd * (q + 1) : r * (q + 1) + (xcd - r) * q) + off; }
        const int nig = WGM * nN, gid = wgid / nig, fm = gid * WGM, gsz = (nM - fm) < WGM ? (nM - fm) : WGM;
        u.pm = fm + ((wgid % nig) % gsz); u.pn = (wgid % nig) / gsz; return true;
    }
    __device__ __forceinline__ void a_ready(const Unit&) const {}
    __device__ __forceinline__ void done(const Unit&) const {}
};

__device__ __forceinline__ unsigned cvt_pk_bf16(float lo, float hi) { unsigned r; asm volatile("v_cvt_pk_bf16_f32 %0, %1, %2" : "=v"(r) : "v"(lo), "v"(hi)); return r; }
template <class Epi, class Sched, bool ALIGN_EPI = false, bool SP2 = false>
__device__ __forceinline__ void gemm_phase(PG8_LAS unsigned char* lds, int tid_in, const Gemm g, const Sched& S, const Epi& E) {
    int tid_ = tid_in; asm volatile("" : "+v"(tid_));
    const int tid = tid_, wid = __builtin_amdgcn_readfirstlane(tid >> 6), lane = tid & 63, wr = wid >> 2, wc = wid & 3, fr = lane & 15, fq = lane >> 4;
    const int K = g.K, nt = K / BK;
    unsigned voffA[2], voffB[2];
#pragma unroll
    for (int i = 0; i < 2; ++i) { int R, C; stage_rc(tid * 16 + i * 8192, R, C); const int Rb = Epi::PERM ? ((R & ~31) + perm32(R & 31)) : R;
        voffA[i] = (unsigned)(R * g.lda + C) * 2u; voffB[i] = (unsigned)(Rb * K + C) * 2u; }
    const size_t kstep = (size_t)(BK * 2);
    const size_t hstepA = (size_t)HALF * g.lda * 2, hstepB = (size_t)HALF * K * 2;
    const size_t tstepA = 2 * hstepA, tstepB = 2 * hstepB;
    const unsigned ldsw = (unsigned)wid * 1024u;
    const int aoff = lds_byte(wr * 64 + fr, fq * 8), boff = lds_byte(wc * 32 + fr, fq * 8);
#define PG8_SA(b, h) (((b) * 2 + (h)) * HTB)
#define PG8_SB(b, h) ((4 + (b) * 2 + (h)) * HTB)
#define PG8_STAGE(bufoff, gbase, voff) do { _Pragma("unroll") for (int _i = 0; _i < 2; ++_i) \
        __builtin_amdgcn_global_load_lds((const unsigned*)((const char*)(gbase) + (voff)[_i]), (PG8_LAS unsigned*)(lds + (bufoff) + ldsw + _i * 8192), 16, 0, 0); } while (0)
#define PG8_LDA(dst, b, h) do { _Pragma("unroll") for (int m = 0; m < 4; ++m) _Pragma("unroll") for (int k = 0; k < 2; ++k) dst[m][k] = *(const PG8_LAS bf16x8*)(lds + PG8_SA(b, h) + aoff + m * 2048 + k * 1024); } while (0)
#define PG8_LDB(dst, b, h) do { _Pragma("unroll") for (int n = 0; n < 2; ++n) _Pragma("unroll") for (int k = 0; k < 2; ++k) dst[n][k] = *(const PG8_LAS bf16x8*)(lds + PG8_SB(b, h) + boff + n * 2048 + k * 1024); } while (0)
#define PG8_MMA(ai, bj, At, Bt) do { __builtin_amdgcn_s_setprio(1); _Pragma("unroll") for (int m = 0; m < 4; ++m) _Pragma("unroll") for (int n = 0; n < 2; ++n) _Pragma("unroll") for (int k = 0; k < 2; ++k) \
        acc[ai][bj][m][n] = __builtin_amdgcn_mfma_f32_16x16x32_bf16(Bt[n][k], At[m][k], acc[ai][bj][m][n], 0, 0, 0); __builtin_amdgcn_s_setprio(0); } while (0)
#define PG8_WAIT_V(n) asm volatile("s_waitcnt vmcnt(" #n ")" ::: "memory")
#define PG8_WAIT_L(n) asm volatile("s_waitcnt lgkmcnt(" #n ")" ::: "memory")
#define PG8_BAR __builtin_amdgcn_s_barrier()
#define PG8_SCHED __builtin_amdgcn_sched_barrier(0)
    Unit cur, nxt; int ui = 0;
    if (!S.next(0, cur)) return;
    f32x4 acc[2][2][4][2];
#pragma unroll
    for (int a = 0; a < 2; ++a)
#pragma unroll
        for (int b = 0; b < 2; ++b)
#pragma unroll
            for (int m = 0; m < 4; ++m)
#pragma unroll
                for (int n = 0; n < 2; ++n) acc[a][b][m][n] = (f32x4){0.f, 0.f, 0.f, 0.f};
    bf16x8 At[4][2], B0[2][2], B1[2][2];
    const char* cA = (const char*)g.A + (size_t)cur.pm * tstepA; const char* cB = (const char*)g.Bt + (size_t)cur.pn * tstepB;
    S.a_ready(cur);
    if constexpr (SP2) {
        PG8_STAGE(PG8_SB(0, 0), cB, voffB); PG8_STAGE(PG8_SB(0, 1), cB + hstepB, voffB); PG8_STAGE(PG8_SA(0, 0), cA, voffA); PG8_STAGE(PG8_SA(0, 1), cA + hstepA, voffA);
        if (wr == 1) PG8_BAR;
        PG8_WAIT_V(2); PG8_BAR;
        PG8_STAGE(PG8_SB(1, 0), cB + kstep, voffB); PG8_STAGE(PG8_SA(1, 0), cA + kstep, voffA); PG8_STAGE(PG8_SB(1, 1), cB + hstepB + kstep, voffB);
        PG8_WAIT_V(6); PG8_BAR;
    } else {
        PG8_STAGE(PG8_SB(0, 0), cB, voffB); PG8_STAGE(PG8_SA(0, 0), cA, voffA); PG8_STAGE(PG8_SB(0, 1), cB + hstepB, voffB); PG8_STAGE(PG8_SA(0, 1), cA + hstepA, voffA);
        if (wr == 1) PG8_BAR;
        PG8_WAIT_V(4); PG8_BAR;
        PG8_STAGE(PG8_SB(1, 0), cB + kstep, voffB); PG8_STAGE(PG8_SA(1, 0), cA + kstep, voffA); PG8_STAGE(PG8_SB(1, 1), cB + hstepB + kstep, voffB);
        PG8_WAIT_V(6); PG8_BAR;
    }
    for (;;) {
        const bool has_next = S.next(ui + 1, nxt);
        const char* nA = has_next ? (const char*)g.A + (size_t)nxt.pm * tstepA : cA; const char* nB = has_next ? (const char*)g.Bt + (size_t)nxt.pn * tstepB : cB;
        for (int t = 0; t < nt; t += 2) {
            const bool last = (t == nt - 2);
            const char* a1 = cA + (size_t)(t + 1) * kstep;
            const char* a2 = last ? nA : cA + (size_t)(t + 2) * kstep; const char* b2 = last ? nB : cB + (size_t)(t + 2) * kstep;
            const char* a3 = a2 + kstep; const char* b3 = b2 + kstep;
            if (last && has_next) S.a_ready(nxt);
            if constexpr (SP2) {
            PG8_LDB(B0, 0, 0); PG8_LDB(B1, 0, 1); PG8_SCHED; PG8_LDA(At, 0, 0); PG8_STAGE(PG8_SA(1, 1), a1 + hstepA, voffA);
            PG8_WAIT_V(8); PG8_WAIT_L(0); PG8_BAR; PG8_MMA(0, 0, At, B0); PG8_MMA(0, 1, At, B1); PG8_BAR; PG8_SCHED;
            PG8_LDA(At, 0, 1); PG8_STAGE(PG8_SB(0, 0), b2, voffB); PG8_STAGE(PG8_SB(0, 1), b2 + hstepB, voffB); PG8_STAGE(PG8_SA(0, 0), a2, voffA);
            PG8_WAIT_V(8); PG8_WAIT_L(0); PG8_BAR; PG8_MMA(1, 0, At, B0); PG8_MMA(1, 1, At, B1); PG8_BAR; PG8_SCHED;
            PG8_LDB(B0, 1, 0); PG8_LDB(B1, 1, 1); PG8_SCHED; PG8_LDA(At, 1, 0); PG8_STAGE(PG8_SA(0, 1), a2 + hstepA, voffA);
            PG8_WAIT_V(8); PG8_WAIT_L(0); PG8_BAR; PG8_MMA(0, 0, At, B0); PG8_MMA(0, 1, At, B1); PG8_BAR; PG8_SCHED;
            PG8_LDA(At, 1, 1); PG8_STAGE(PG8_SB(1, 0), b3, voffB); PG8_STAGE(PG8_SB(1, 1), b3 + hstepB, voffB); PG8_STAGE(PG8_SA(1, 0), a3, voffA);
            PG8_WAIT_V(8); PG8_WAIT_L(0); PG8_BAR; PG8_MMA(1, 0, At, B0); PG8_MMA(1, 1, At, B1); PG8_BAR; PG8_SCHED;
            } else {
            PG8_LDB(B0, 0, 0); PG8_SCHED; PG8_LDA(At, 0, 0); PG8_STAGE(PG8_SA(1, 1), a1 + hstepA, voffA);
            PG8_WAIT_L(8); PG8_BAR; PG8_WAIT_L(0); PG8_MMA(0, 0, At, B0); PG8_BAR; PG8_SCHED;
            PG8_LDB(B1, 0, 1); PG8_STAGE(PG8_SB(0, 0), b2, voffB);
            PG8_BAR; PG8_WAIT_L(0); PG8_MMA(0, 1, At, B1); PG8_BAR;
            PG8_LDA(At, 0, 1); PG8_STAGE(PG8_SA(0, 0), a2, voffA);
            PG8_BAR; PG8_WAIT_L(0); PG8_MMA(1, 0, At, B0); PG8_BAR; PG8_SCHED;
            PG8_STAGE(PG8_SB(0, 1), b2 + hstepB, voffB);
            PG8_WAIT_V(6); PG8_BAR; PG8_MMA(1, 1, At, B1); PG8_BAR;
            PG8_LDB(B0, 1, 0); PG8_SCHED; PG8_LDA(At, 1, 0); PG8_STAGE(PG8_SA(0, 1), a2 + hstepA, voffA);
            PG8_WAIT_L(8); PG8_BAR; PG8_WAIT_L(0); PG8_MMA(0, 0, At, B0); PG8_BAR; PG8_SCHED;
            PG8_LDB(B1, 1, 1); PG8_STAGE(PG8_SB(1, 0), b3, voffB);
            PG8_BAR; PG8_WAIT_L(0); PG8_MMA(0, 1, At, B1); PG8_BAR;
            PG8_LDA(At, 1, 1); PG8_STAGE(PG8_SA(1, 0), a3, voffA);
            PG8_BAR; PG8_WAIT_L(0); PG8_MMA(1, 0, At, B0); PG8_BAR; PG8_SCHED;
            PG8_STAGE(PG8_SB(1, 1), b3 + hstepB, voffB);
            PG8_WAIT_V(6); PG8_BAR; PG8_MMA(1, 1, At, B1); PG8_BAR;
            }
        }
        if constexpr (ALIGN_EPI) { if (wr == 0) PG8_BAR; }
        if constexpr (!Epi::AFTER_DRAIN) { E(acc, cur, wr, wc, fr, fq); S.done(cur); }
        if (!has_next) break;
#pragma unroll
        for (int a = 0; a < 2; ++a)
#pragma unroll
            for (int b = 0; b < 2; ++b)
#pragma unroll
                for (int m = 0; m < 4; ++m)
#pragma unroll
                    for (int n = 0; n < 2; ++n) acc[a][b][m][n] = (f32x4){0.f, 0.f, 0.f, 0.f};
        cur = nxt; cA = nA; cB = nB; ++ui;
        if constexpr (ALIGN_EPI) { if (wr == 1) PG8_BAR; }
    }
    PG8_WAIT_V(0);
    if constexpr (!ALIGN_EPI) { if (wr == 0) PG8_BAR; }
    PG8_BAR;
    if constexpr (Epi::AFTER_DRAIN) { E.fused(acc, cur, wr, wc, fr, fq, lds, wid, lane); S.done(cur); }
#undef PG8_SA
#undef PG8_SB
#undef PG8_STAGE
#undef PG8_LDA
#undef PG8_LDB
#undef PG8_MMA
#undef PG8_WAIT_V
#undef PG8_WAIT_L
#undef PG8_BAR
#undef PG8_SCHED
}
}
#define LAS __attribute__((address_space(3)))
typedef unsigned short bf16_t;
typedef short bf16x8 __attribute__((ext_vector_type(8)));
typedef short s16x4 __attribute__((ext_vector_type(4)));
typedef float f32x4 __attribute__((ext_vector_type(4)));
typedef float f32x16 __attribute__((ext_vector_type(16)));
typedef unsigned u32x4 __attribute__((ext_vector_type(4)));
typedef unsigned u32x2 __attribute__((ext_vector_type(2)));

constexpr int MT = 16384, SEQL = 4096;
constexpr float EPSN = 1e-6f;
constexpr size_t MiB = (size_t)1 << 20;
constexpr size_t WS_SSQ_QA = 0, WS_SSQ_KV = 65536, WS_SSQ_X1 = 131072, WS_SSQ_X2 = 196608;
constexpr size_t WS_KC = 1 * MiB, WS_VC = 2 * MiB, WS_KPE = 4 * MiB;
constexpr size_t WS_WIN_T = 8 * MiB, WS_WQB_T = 53 * MiB, WS_WKVB_T = 56 * MiB, WS_PA_T = 60 * MiB, WS_PB_T = 68 * MiB, WS_WOUT_T = 76 * MiB;
constexpr size_t WS_WQC_T = 84 * MiB, WS_WKC_T = 86 * MiB, WS_WVC_T = 88 * MiB, WS_WOC_T = 90 * MiB, WS_MEMN = 92 * MiB;
constexpr size_t WS_Z1 = 96 * MiB, WS_U = 200 * MiB, WS_KN = 264 * MiB, WS_V = 328 * MiB, WS_YA = 392 * MiB, WS_ROPE = 456 * MiB;
constexpr size_t WS_Z2A = 264 * MiB, WS_YB = 200 * MiB, WS_TA = 96 * MiB, WS_X1B = 200 * MiB, WS_QC = 264 * MiB, WS_OC = 280 * MiB;
constexpr size_t WS_WUP_T = 8 * MiB, WS_WDN_T = 52 * MiB, WS_X2B = 426 * MiB, WS_H1 = 74 * MiB, WS_H2 = 250 * MiB, WS_NEED = 490 * MiB;
constexpr size_t WS_WING = 481 * MiB;
constexpr size_t WS_SC = 460 * MiB, WS_GV = 476 * MiB;
constexpr size_t O_QN = 0, O_QPE = 64 * MiB, O_Z2B = 0;
constexpr int Z1_LD = 3328, Z2_LD = 4096;
constexpr int LDS_BYTES = 147456, LDS_EPI = 131072;
constexpr int NPHASE = 14;
constexpr size_t WS_BAR = 6 * MiB, BAR_BYTES = 16384;
constexpr int LDS_MISC = LDS_BYTES - 64;
constexpr int NML = 32;

__device__ __forceinline__ float bf2f(unsigned short v) { return __uint_as_float(((unsigned)v) << 16); }
__device__ __forceinline__ float bflo(unsigned w) { return __uint_as_float(w << 16); }
__device__ __forceinline__ float bfhi(unsigned w) { return __uint_as_float(w & 0xffff0000u); }
__device__ __forceinline__ unsigned pk2(float lo, float hi) { return pg8::cvt_pk_bf16(lo, hi); }
__device__ __forceinline__ float wave_sum(float v) {
#pragma unroll
    for (int o = 1; o < 64; o <<= 1) v += __shfl_xor(v, o);
    return v;
}
__device__ __forceinline__ float sigm(float x) { return 1.f / (1.f + __expf(-x)); }
__device__ __forceinline__ void unpack8(const u32x4 w, float (&f)[8]) {
    f[0] = bflo(w.x); f[1] = bfhi(w.x); f[2] = bflo(w.y); f[3] = bfhi(w.y); f[4] = bflo(w.z); f[5] = bfhi(w.z); f[6] = bflo(w.w); f[7] = bfhi(w.w);
}
__device__ __forceinline__ u32x4 pack8(const float (&f)[8]) { u32x4 w; w.x = pk2(f[0], f[1]); w.y = pk2(f[2], f[3]); w.z = pk2(f[4], f[5]); w.w = pk2(f[6], f[7]); return w; }
#define LDS_WAIT() asm volatile("s_waitcnt lgkmcnt(0)" ::: "memory")

#define XB_TMO      128
#define XB_XCNT(j)  (256  + 64 * (j))
#define XB_XSUB(j)  (1280 + 64 * (j))
#define XB_XGEN(j)  (2304 + 64 * (j))
#define XB_TOP      3328
#define XB_TOPGEN   3392
#define XCD_BAR_WORDS 3456
#define XB_SPIN_CAP (1u << 18)

__device__ __forceinline__ unsigned xb_ld(unsigned* p)              { return __hip_atomic_load(p, __ATOMIC_RELAXED, __HIP_MEMORY_SCOPE_AGENT); }
__device__ __forceinline__ unsigned xb_add(unsigned* p, unsigned v) { return __hip_atomic_fetch_add(p, v, __ATOMIC_RELAXED, __HIP_MEMORY_SCOPE_AGENT); }
__device__ __forceinline__ unsigned xb_xcc_id() { return (unsigned)__builtin_amdgcn_s_getreg((3 << 11) | 20) & 0xFu; }
#define XB_SPIN(cond, bar) do { unsigned _sp = 0; while (cond) { __builtin_amdgcn_s_sleep(1); \
    if ((++_sp & 255u) == 0u) { if (xb_ld(&(bar)[XB_TMO])) break; if (_sp > XB_SPIN_CAP) { atomicAdd(&(bar)[XB_TMO], 1u); break; } } } } while (0)

struct XcdBarrier {
    unsigned* bar; unsigned x;
    volatile LAS unsigned* st;
};

__device__ __forceinline__ XcdBarrier xcd_barrier_post(unsigned* bar, volatile LAS unsigned* st) {
    XcdBarrier b; b.bar = bar; b.x = xb_xcc_id(); b.st = st;
    if (threadIdx.x == 0) (void)xb_add(&bar[XB_XCNT(b.x)], 1u);
    return b;
}
__device__ __forceinline__ void xcd_barrier_complete(unsigned* bar, unsigned x, unsigned& nloc, unsigned& nx) {
    const unsigned G = gridDim.x * gridDim.y * gridDim.z;
    unsigned sum, cnt, mine, sp = 0u;
    for (;;) {
        sum = 0u; cnt = 0u; mine = 0u;
#pragma unroll
        for (unsigned j = 0; j < 16; ++j) { const unsigned c = xb_ld(&bar[XB_XCNT(j)]); sum += c; cnt += (c > 0u) ? 1u : 0u; mine = (j == x) ? c : mine; }
        if (sum == G) break;
        __builtin_amdgcn_s_sleep(1);
        if ((++sp & 255u) == 0u) { if (xb_ld(&bar[XB_TMO])) break; if (sp > XB_SPIN_CAP) { atomicAdd(&bar[XB_TMO], 1u); break; } }
    }
    nloc = mine > 0u ? mine : 1u; nx = cnt > 0u ? cnt : 1u;
}

__device__ __forceinline__ void xcd_barrier(const XcdBarrier& b) {
    asm volatile("s_waitcnt vmcnt(0)" ::: "memory");
    __syncthreads();
    if (threadIdx.x == 0) {
        unsigned* bar = b.bar;
        __builtin_amdgcn_s_waitcnt(0);
        unsigned nloc = b.st[0], nx = b.st[1];
        if (nloc == 0u) { xcd_barrier_complete(bar, b.x, nloc, nx); b.st[0] = nloc; b.st[1] = nx; }
        const unsigned old = xb_add(&bar[XB_XSUB(b.x)], 1u);
        const unsigned gen = old / nloc;
        if (old + 1u == (gen + 1u) * nloc) {
            __builtin_amdgcn_fence(__ATOMIC_RELEASE, "agent");
            asm volatile("s_waitcnt vmcnt(0)" ::: "memory");
            const unsigned og = xb_add(&bar[XB_TOP], 1u);
            const unsigned tg = og / nx;
            if (og + 1u == (tg + 1u) * nx) xb_add(&bar[XB_TOPGEN], 1u);
            else XB_SPIN(xb_ld(&bar[XB_TOPGEN]) == tg, bar);
            __builtin_amdgcn_fence(__ATOMIC_ACQUIRE, "agent");
            xb_add(&bar[XB_XGEN(b.x)], 1u);
            asm volatile("s_waitcnt vmcnt(0)" ::: "memory");
        } else {
            XB_SPIN(xb_ld(&bar[XB_XGEN(b.x)]) == gen, bar);
            __builtin_amdgcn_fence(__ATOMIC_ACQUIRE, "agent");
            asm volatile("s_waitcnt vmcnt(0)" ::: "memory");
        }
    }
    __syncthreads();
}

struct Args { const float* in[32]; float* out; unsigned char* ws; int ph_lo, ph_hi; };
typedef const Args __attribute__((address_space(4)))* ArgsP;
enum { EM_Z1 = 0, EM_Z2, EM_ZG, EM_GA, EM_GB, EM_UP, EM_Q, EM_KV, EM_QC, EM_KC, EM_VC };
struct EpiBF {
    static constexpr bool PERM = true, AFTER_DRAIN = false;
    int mode; ArgsP a0; LAS float* P;
    __device__ __forceinline__ void operator()(const pg8::f32x4 (&acc)[2][2][4][2], const pg8::Unit& u, int wr, int wc, int fr, int fq) const {
        ArgsP a = a0; asm volatile("" : "+s"(a));
        unsigned char* ws = a->ws; unsigned char* ob = (unsigned char*)a->out;
        int kind = 0; bf16_t* dst = nullptr; int ldc = 2048, colb = u.pn * 256; bool sig = false, presc = false, addt = false; float* ssq = nullptr; const bf16_t* gt = nullptr; int gcol = 0;
        const float* rs_ssq = nullptr; float rs_invn = 0.f; const float* gain0 = nullptr; const float* gain1 = nullptr;
        const float* ropec = (const float*)(ws + WS_ROPE); const float* ropes = ropec + (size_t)MT * 32;
        switch (mode) {
            case EM_Z1: dst = (bf16_t*)(ws + WS_Z1); ldc = Z1_LD; ssq = u.pn < 2 ? (float*)(ws + WS_SSQ_QA) : (u.pn < 4 ? (float*)(ws + WS_SSQ_KV) : nullptr); break;
            case EM_Z2: ldc = Z2_LD; sig = u.pn >= 8; dst = (bf16_t*)(ws + WS_Z2A); gain0 = a->in[15]; break;
            case EM_ZG: ldc = Z2_LD; sig = true; dst = (bf16_t*)(ob + O_Z2B); break;
            case EM_GA: dst = (bf16_t*)(ws + WS_TA); gt = (const bf16_t*)(ob + O_Z2B); gcol = colb; break;
            case EM_GB: dst = (bf16_t*)(ws + WS_TA); gt = (const bf16_t*)(ob + O_Z2B); gcol = 2048 + colb; addt = true; break;
            case EM_UP: presc = true; rs_ssq = (const float*)(ws + WS_SSQ_X2); rs_invn = 1.f / 2048.f; ldc = 5632; if (u.pn >= 22) { dst = (bf16_t*)(ws + WS_H2); colb = (u.pn - 22) * 256; } else dst = (bf16_t*)(ws + WS_H1); break;
            case EM_Q: presc = true; rs_ssq = (const float*)(ws + WS_SSQ_QA); rs_invn = 1.f / 512.f; gain0 = a->in[9]; gain1 = a->in[10];
                       if (u.pn < 8) { kind = 1; dst = (bf16_t*)(ob + O_QN); } else { kind = 2; dst = (bf16_t*)(ob + O_QPE); ldc = 1024; colb = (u.pn - 8) * 256; } break;
            case EM_KV: presc = true; rs_ssq = (const float*)(ws + WS_SSQ_KV); rs_invn = 1.f / 512.f; gain0 = a->in[11];
                       if (u.pn < 8) { kind = 1; dst = (bf16_t*)(ws + WS_KN); } else { dst = (bf16_t*)(ws + WS_V); colb = (u.pn - 8) * 256; } break;
            case EM_QC: presc = true; rs_ssq = (const float*)(ws + WS_SSQ_X1); rs_invn = 1.f / 2048.f; gain0 = a->in[24]; kind = 1; ldc = 512; dst = (bf16_t*)(ws + WS_QC); break;
            case EM_KC: kind = 1; ldc = 512; gain0 = a->in[25]; dst = (bf16_t*)(ws + WS_KC); break;
            default: ldc = 512; dst = (bf16_t*)(ws + WS_VC); break;
        }
        const int rowb = u.pm * 256 + wr * 64 + fr;
        const int cl = wc * 32 + 8 * fq;
        float rs8[2][4];
#pragma unroll
        for (int ai = 0; ai < 2; ++ai)
#pragma unroll
            for (int m = 0; m < 4; ++m) rs8[ai][m] = presc ? rs_ssq[rowb + ai * 128 + m * 16] : 0.f;
#pragma unroll
        for (int ai = 0; ai < 2; ++ai)
#pragma unroll
            for (int m = 0; m < 4; ++m) rs8[ai][m] = presc ? rsqrtf(rs8[ai][m] * rs_invn + EPSN) : 1.f;
        if (kind == 1) {
#pragma unroll
            for (int ai = 0; ai < 2; ++ai)
#pragma unroll
                for (int m = 0; m < 4; ++m) {
                    const int rl = ai * 128 + wr * 64 + m * 16 + fr;
                    const float rsv = rs8[ai][m];
#pragma unroll
                    for (int bj = 0; bj < 2; ++bj) {
                        float s = 0.f;
#pragma unroll
                        for (int n = 0; n < 2; ++n)
#pragma unroll
                            for (int j = 0; j < 4; ++j) { const float v = acc[ai][bj][m][n][j] * rsv; s += v * v; }
                        s += __shfl_xor(s, 16); s += __shfl_xor(s, 32);
                        if (fq == 0) P[rl * 8 + bj * 4 + wc] = s;
                    }
                }
            LDS_WAIT(); __builtin_amdgcn_s_barrier(); asm volatile("" ::: "memory");
            float g8[8];
            { const f32x4 ga = *(const f32x4*)(gain0 + cl), gb = *(const f32x4*)(gain0 + cl + 4); g8[0] = ga[0]; g8[1] = ga[1]; g8[2] = ga[2]; g8[3] = ga[3]; g8[4] = gb[0]; g8[5] = gb[1]; g8[6] = gb[2]; g8[7] = gb[3]; }
#pragma unroll
            for (int ai = 0; ai < 2; ++ai)
#pragma unroll
                for (int m = 0; m < 4; ++m) {
                    const int rl = ai * 128 + wr * 64 + m * 16 + fr; const int row = u.pm * 256 + rl;
                    const float rsv = rs8[ai][m];
#pragma unroll
                    for (int bj = 0; bj < 2; ++bj) {
                        const f32x4 p4 = *(const LAS f32x4*)(P + rl * 8 + bj * 4);
                        const float rn = rsqrtf(((p4[0] + p4[1]) + (p4[2] + p4[3])) * (1.f / 128.f) + EPSN) * rsv;
                        float o[8];
#pragma unroll
                        for (int n = 0; n < 2; ++n)
#pragma unroll
                            for (int j = 0; j < 4; ++j) o[4 * n + j] = acc[ai][bj][m][n][j] * rn * g8[4 * n + j];
                        *(u32x4*)(dst + (size_t)row * ldc + colb + bj * 128 + cl) = pack8(o);
                    }
                    asm volatile("" ::: "memory");
                }
        } else if (kind == 2) {
            const int hq = 4 * (u.pn - 8) + wc;
#pragma unroll
            for (int ai = 0; ai < 2; ++ai)
#pragma unroll
                for (int m = 0; m < 4; ++m) {
                    const int row = rowb + ai * 128 + m * 16;
                    const float rsv = rs8[ai][m];
                    float s = 0.f;
#pragma unroll
                    for (int bj = 0; bj < 2; ++bj)
#pragma unroll
                        for (int n = 0; n < 2; ++n)
#pragma unroll
                            for (int j = 0; j < 4; ++j) { const float v = acc[ai][bj][m][n][j] * rsv; s += v * v; }
                    s += __shfl_xor(s, 16); s += __shfl_xor(s, 32);
                    const float rn = rsqrtf(s * (1.f / 64.f) + EPSN) * rsv;
                    bf16_t* p = dst + (size_t)row * 1024 + 64 * hq + 8 * fq;
#pragma unroll
                    for (int n = 0; n < 2; ++n) {
                        const f32x4 cc = *(const f32x4*)(ropec + (size_t)row * 32 + 8 * fq + 4 * n), ss = *(const f32x4*)(ropes + (size_t)row * 32 + 8 * fq + 4 * n);
                        const f32x4 ga = *(const f32x4*)(gain1 + 8 * fq + 4 * n), gb = *(const f32x4*)(gain1 + 32 + 8 * fq + 4 * n);
                        float o1[4], o2[4];
#pragma unroll
                        for (int j = 0; j < 4; ++j) {
                            const float x1 = acc[ai][0][m][n][j] * rn * ga[j], x2 = acc[ai][1][m][n][j] * rn * gb[j];
                            o1[j] = x1 * cc[j] - x2 * ss[j]; o2[j] = x2 * cc[j] + x1 * ss[j];
                        }
                        u32x2 w1, w2; w1.x = pk2(o1[0], o1[1]); w1.y = pk2(o1[2], o1[3]); w2.x = pk2(o2[0], o2[1]); w2.y = pk2(o2[2], o2[3]);
                        *(u32x2*)(p + 4 * n) = w1; *(u32x2*)(p + 32 + 4 * n) = w2;
                        asm volatile("" ::: "memory");
                    }
                }
        } else {
#pragma unroll
            for (int ai = 0; ai < 2; ++ai)
#pragma unroll
                for (int m = 0; m < 4; ++m) {
                    const int row = rowb + ai * 128 + m * 16;
                    const float rsv = rs8[ai][m];
                    float sacc = 0.f;
#pragma unroll
                    for (int bj = 0; bj < 2; ++bj) {
                        float o[8];
#pragma unroll
                        for (int n = 0; n < 2; ++n)
#pragma unroll
                            for (int j = 0; j < 4; ++j) o[4 * n + j] = acc[ai][bj][m][n][j] * rsv;
                        if (sig) {
#pragma unroll
                            for (int e = 0; e < 8; ++e) o[e] = sigm(o[e]);
                            if (mode == EM_Z2) { const f32x4 h0 = *(const f32x4*)(gain0 + colb - 2048 + bj * 128 + cl), h1_ = *(const f32x4*)(gain0 + colb - 2048 + bj * 128 + cl + 4);
#pragma unroll
                                for (int e = 0; e < 4; ++e) { o[e] *= h0[e]; o[4 + e] *= h1_[e]; } }
                        }
                        if (gt) { float gv[8]; unpack8(*(const u32x4*)(gt + (size_t)row * Z2_LD + gcol + bj * 128 + cl), gv);
#pragma unroll
                            for (int e = 0; e < 8; ++e) o[e] *= gv[e]; }
                        bf16_t* p = dst + (size_t)row * ldc + colb + bj * 128 + cl;
                        if (addt) { float tv[8]; unpack8(*(const u32x4*)p, tv);
#pragma unroll
                            for (int e = 0; e < 8; ++e) o[e] += tv[e]; }
                        if (ssq) {
#pragma unroll
                            for (int e = 0; e < 8; ++e) sacc += o[e] * o[e]; }
                        if (mode == EM_UP) __builtin_nontemporal_store(pack8(o), (u32x4*)p); else *(u32x4*)p = pack8(o);
                    }
                    if (ssq) { sacc += __shfl_xor(sacc, 16); sacc += __shfl_xor(sacc, 32); if (fq == 0) atomicAdd(ssq + row, sacc); }
                    asm volatile("" ::: "memory");
                }
        }
    }
};
struct EpiF32 {
    static constexpr bool PERM = false, AFTER_DRAIN = false;
    int mode; ArgsP a0;
    __device__ __forceinline__ void operator()(const pg8::f32x4 (&acc)[2][2][4][2], const pg8::Unit& u, int wr, int wc, int fr, int fq) const {
        ArgsP a = a0; asm volatile("" : "+s"(a));
        unsigned char* ws = a->ws; float* out = a->out; const float* base = mode == 0 ? a->in[0] : (const float*)out;
        bf16_t* aux = mode == 0 ? (bf16_t*)(ws + WS_X1B) : mode == 1 ? (bf16_t*)(ws + WS_X2B) : nullptr; float* ssq = mode == 0 ? (float*)(ws + WS_SSQ_X1) : (float*)(ws + WS_SSQ_X2);
        const int rowb = u.pm * 256 + wr * 64 + fr, cb = u.pn * 256 + wc * 32 + 4 * fq;
#pragma unroll
        for (int ai = 0; ai < 2; ++ai) {
            f32x4 pre[4][2][2];
#pragma unroll
            for (int m = 0; m < 4; ++m)
#pragma unroll
                for (int bj = 0; bj < 2; ++bj)
#pragma unroll
                    for (int n = 0; n < 2; ++n) pre[m][bj][n] = *(const f32x4*)(base + (size_t)(rowb + ai * 128 + m * 16) * 2048 + cb + bj * 128 + n * 16);
#pragma unroll
            for (int m = 0; m < 4; ++m) {
                const int row = rowb + ai * 128 + m * 16; float s = 0.f;
#pragma unroll
                for (int bj = 0; bj < 2; ++bj)
#pragma unroll
                    for (int n = 0; n < 2; ++n) {
                        const size_t off = (size_t)row * 2048 + cb + bj * 128 + n * 16;
                        const f32x4 o = pre[m][bj][n] + acc[ai][bj][m][n];
                        *(f32x4*)(out + off) = o;
                        if (aux) { s += (o[0] * o[0] + o[1] * o[1]) + (o[2] * o[2] + o[3] * o[3]); u32x2 w; w.x = pk2(o[0], o[1]); w.y = pk2(o[2], o[3]); *(u32x2*)(aux + off) = w; }
                    }
                if (aux) { s += __shfl_xor(s, 16); s += __shfl_xor(s, 32); if (fq == 0) atomicAdd(ssq + row, s); }
            }
            asm volatile("" ::: "memory");
        }
    }
};
#define MFMA32(a, b, c) __builtin_amdgcn_mfma_f32_32x32x16_bf16((a), (b), (c), 0, 0, 0)
typedef short v4i16_t __attribute__((ext_vector_type(4)));
__device__ __forceinline__ s16x4 trread(const LAS unsigned char* p) { return __builtin_bit_cast(s16x4, __builtin_amdgcn_ds_read_tr16_b64_v4i16((LAS v4i16_t*)p)); }
__device__ __forceinline__ bf16x8 cat44(s16x4 lo, s16x4 hi) { return (bf16x8){lo[0], lo[1], lo[2], lo[3], hi[0], hi[1], hi[2], hi[3]}; }
__device__ __forceinline__ bf16x8 packacc8(const f32x16& x, int b) {
    u32x4 w; w.x = pk2(x[b], x[b + 1]); w.y = pk2(x[b + 2], x[b + 3]); w.z = pk2(x[b + 4], x[b + 5]); w.w = pk2(x[b + 6], x[b + 7]); return __builtin_bit_cast(bf16x8, w);
}
template <int NKS, bool ALLIN = false>
__device__ __forceinline__ void attn_unit(LAS unsigned char* lds, int tid_in, const bf16_t* qn, int ldqn, const bf16_t* qpe, int ldqpe, const bf16_t* kn, int ldkn, const bf16_t* kpe, int ldkpe,
                                          const bf16_t* vv, int ldv, bf16_t* out, int ldo, int NT, int my_nt, float c2) {
    constexpr int KSTR = NKS * 32 + 16, VSTR = ALLIN ? 288 : 320, KBUF = 64 * KSTR, VBUF = 64 * VSTR, NKB = ALLIN ? 4 : 2;
    int tid_ = tid_in; asm volatile("" : "+v"(tid_)); const int tid = tid_, lane = tid & 63, wid = __builtin_amdgcn_readfirstlane(tid >> 6), r = lane & 31, hh = lane >> 5;
    bf16x8 qf[NKS];
#pragma unroll
    for (int ks = 0; ks < NKS; ++ks) {
        if (ks < 8) qf[ks] = *(const bf16x8*)(qn + (size_t)(wid * 32 + r) * ldqn + ks * 16 + hh * 8);
        else qf[ks] = *(const bf16x8*)(qpe + (size_t)(wid * 32 + r) * ldqpe + (ks - 8) * 16 + hh * 8);
    }
    const int key0 = tid >> 4, ch0 = tid & 15;
    const int keyp = tid >> 3, chp = tid & 7;
    u32x4 rk0, rk1, rkp, rv0, rv1;
#define ATT_LOAD(t) do { const size_t kb_ = (size_t)(t) * 64; \
        rk0 = *(const u32x4*)(kn + (kb_ + key0) * ldkn + ch0 * 8); rk1 = *(const u32x4*)(kn + (kb_ + key0 + 32) * ldkn + ch0 * 8); \
        if (NKS > 8) rkp = *(const u32x4*)(kpe + (kb_ + keyp) * ldkpe + chp * 8); \
        rv0 = *(const u32x4*)(vv + (kb_ + key0) * ldv + ch0 * 8); rv1 = *(const u32x4*)(vv + (kb_ + key0 + 32) * ldv + ch0 * 8); } while (0)
#define ATT_STORE(buf) do { LAS unsigned char* kb_ = lds + (buf) * KBUF; LAS unsigned char* vb_ = lds + NKB * KBUF + (buf) * VBUF; \
        *(LAS u32x4*)(kb_ + key0 * KSTR + ch0 * 16) = rk0; *(LAS u32x4*)(kb_ + (key0 + 32) * KSTR + ch0 * 16) = rk1; \
        if (NKS > 8) *(LAS u32x4*)(kb_ + keyp * KSTR + 256 + chp * 16) = rkp; \
        *(LAS u32x4*)(vb_ + key0 * VSTR + ch0 * 16) = rv0; *(LAS u32x4*)(vb_ + (key0 + 32) * VSTR + ch0 * 16) = rv1; } while (0)
    if constexpr (ALLIN) {
        u32x4 ak0[4], ak1[4], av0[4], av1[4];
#pragma unroll
        for (int t = 0; t < 4; ++t) { ATT_LOAD(t); ak0[t] = rk0; ak1[t] = rk1; av0[t] = rv0; av1[t] = rv1; }
#pragma unroll
        for (int t = 0; t < 4; ++t) { rk0 = ak0[t]; rk1 = ak1[t]; rv0 = av0[t]; rv1 = av1[t]; ATT_STORE(t); }
    } else { ATT_LOAD(0); ATT_STORE(0); }
    __syncthreads();
    f32x16 o[4];
#pragma unroll
    for (int d = 0; d < 4; ++d)
#pragma unroll
        for (int i = 0; i < 16; ++i) o[d][i] = 0.f;
    float mrun = -INFINITY, lrun = 0.f;
    const int g4 = lane >> 4, i16 = lane & 15, q4 = i16 >> 2, p4 = i16 & 3;
    const int vlane = (4 * hh + q4) * VSTR + (16 * (g4 & 1) + 4 * p4) * 2;
#pragma nounroll
    for (int t = 0; t < NT; ++t) {
        if (!ALLIN && t + 1 < NT) ATT_LOAD(t + 1);
        if (t < my_nt) {
            const int bi_ = ALLIN ? t : (t & 1);
            const LAS unsigned char* Kb = lds + bi_ * KBUF; const LAS unsigned char* Vb = lds + NKB * KBUF + bi_ * VBUF;
            f32x16 s0, s1;
#pragma unroll
            for (int i = 0; i < 16; ++i) { s0[i] = 0.f; s1[i] = 0.f; }
            bf16x8 ka[2][2][2];
#define ATT_LDK(buf, g) do { _Pragma("unroll") for (int kk = 0; kk < 2; ++kk) { \
                ka[buf][kk][0] = *(const LAS bf16x8*)(Kb + r * KSTR + (2 * (g) + kk) * 32 + hh * 16); ka[buf][kk][1] = *(const LAS bf16x8*)(Kb + (32 + r) * KSTR + (2 * (g) + kk) * 32 + hh * 16); } } while (0)
            ATT_LDK(0, 0); ATT_LDK(1, 1);
            __builtin_amdgcn_sched_barrier(0);
#pragma unroll
            for (int g = 0; g < NKS / 2; ++g) {
#pragma unroll
                for (int kk = 0; kk < 2; ++kk) { s0 = MFMA32(ka[g & 1][kk][0], qf[2 * g + kk], s0); s1 = MFMA32(ka[g & 1][kk][1], qf[2 * g + kk], s1); }
                __builtin_amdgcn_sched_barrier(0);
                if (g + 2 < NKS / 2) { ATT_LDK(g & 1, g + 2); __builtin_amdgcn_sched_barrier(0); }
            }
#undef ATT_LDK
            s16x4 vl[2][4], vh[2][4];
#define ATT_LDV(buf, d) do { _Pragma("unroll") for (int kb = 0; kb < 2; ++kb) _Pragma("unroll") for (int s = 0; s < 2; ++s) { \
                const LAS unsigned char* p_ = Vb + vlane + (32 * kb + 16 * s) * VSTR + (d) * 64; vl[buf][2 * kb + s] = trread(p_); vh[buf][2 * kb + s] = trread(p_ + 8 * VSTR); } } while (0)
            ATT_LDV(0, 0); ATT_LDV(1, 1);
            __builtin_amdgcn_sched_barrier(0);
            float mx = -INFINITY;
#pragma unroll
            for (int i = 0; i < 16; ++i) mx = fmaxf(mx, fmaxf(s0[i], s1[i]));
            mx = fmaxf(mx, __shfl_xor(mx, 32)) * c2;
            const float mnew = fmaxf(mrun, mx), alpha = __builtin_amdgcn_exp2f(mrun - mnew); mrun = mnew;
            float ls = 0.f;
#pragma unroll
            for (int i = 0; i < 16; ++i) { s0[i] = __builtin_amdgcn_exp2f(fmaf(s0[i], c2, -mnew)); s1[i] = __builtin_amdgcn_exp2f(fmaf(s1[i], c2, -mnew)); ls += s0[i] + s1[i]; }
            lrun = lrun * alpha + ls;
#pragma unroll
            for (int d = 0; d < 4; ++d)
#pragma unroll
                for (int i = 0; i < 16; ++i) o[d][i] *= alpha;
            bf16x8 pf[4];
            pf[0] = packacc8(s0, 0); pf[1] = packacc8(s0, 8); pf[2] = packacc8(s1, 0); pf[3] = packacc8(s1, 8);
            __builtin_amdgcn_sched_barrier(0);
#pragma unroll
            for (int d = 0; d < 4; ++d) {
#pragma unroll
                for (int j = 0; j < 4; ++j) o[d] = MFMA32(cat44(vl[d & 1][j], vh[d & 1][j]), pf[j], o[d]);
                __builtin_amdgcn_sched_barrier(0);
                if (d + 2 < 4) { ATT_LDV(d & 1, d + 2); __builtin_amdgcn_sched_barrier(0); }
            }
#undef ATT_LDV
        }
        if constexpr (!ALLIN) { if (t + 1 < NT) ATT_STORE((t + 1) & 1); __syncthreads(); }
    }
    if constexpr (ALLIN) __syncthreads();
    const float lt = lrun + __shfl_xor(lrun, 32), inv = 1.f / lt;
#pragma unroll
    for (int d = 0; d < 4; ++d)
#pragma unroll
        for (int g = 0; g < 4; ++g) {
            u32x2 w; w.x = pk2(o[d][4 * g] * inv, o[d][4 * g + 1] * inv); w.y = pk2(o[d][4 * g + 2] * inv, o[d][4 * g + 3] * inv);
            *(u32x2*)(out + (size_t)(wid * 32 + r) * ldo + d * 32 + 8 * g + 4 * hh) = w;
        }
#undef ATT_LOAD
#undef ATT_STORE
}

constexpr size_t GV_WI = WS_GV, GV_EI = WS_GV + 512 * 1024, GV_A = WS_GV + 1024 * 1024, GV_R = WS_GV + 1536 * 1024, GV_U = WS_GV + 2048 * 1024, GV_DI = WS_GV + 2560 * 1024,
                 GV_DEC = WS_GV + 3072 * 1024, GV_DN = WS_GV + 3072 * 1024 + 65536;
__device__ __forceinline__ void gate_scan(LAS unsigned char* lds, int tid_in, int b, int h, const bf16_t* z1, const float* b_if, unsigned char* ws) {
    float* WIg = (float*)(ws + GV_WI); float* EIg = (float*)(ws + GV_EI); float* Ag = (float*)(ws + GV_A); float* Rg = (float*)(ws + GV_R); float* Ug = (float*)(ws + GV_U); float* DECg = (float*)(ws + GV_DEC);
    LAS float* BL = (LAS float*)lds; LAS float* PL = BL + 64; LAS float* MC = BL + 128;
    int tid_ = tid_in; asm volatile("" : "+v"(tid_)); const int tid = tid_, lane = tid & 63, wid = __builtin_amdgcn_readfirstlane(tid >> 6);
    const float bi = b_if[h], bfb = b_if[8 + h];
    const bf16_t* zp = z1 + ((size_t)b * SEQL + lane) * Z1_LD + 1088 + h;
    unsigned short ri[8], rf[8];
#pragma unroll
    for (int j = 0; j < 8; ++j) { const size_t c = wid * 8 + j; ri[j] = zp[c * 64 * Z1_LD]; rf[j] = zp[c * 64 * Z1_LD + 8]; }
    float bc[8], av[8], pm[8];
#pragma unroll
    for (int j = 0; j < 8; ++j) {
        const float gi = bf2f(ri[j]) + bi, xf = bf2f(rf[j]) + bfb;
        const float lf = fminf(xf, 0.f) - log1pf(__expf(-fabsf(xf)));
        float bcum = lf;
#pragma unroll
        for (int o = 1; o < 64; o <<= 1) { const float t = __shfl_up(bcum, o); if (lane >= o) bcum += t; }
        const float a = gi - bcum;
        float p = a;
#pragma unroll
        for (int o = 1; o < 64; o <<= 1) { const float t = __shfl_up(p, o); if (lane >= o) p = fmaxf(p, t); }
        bc[j] = bcum; av[j] = a; pm[j] = p;
        if (lane == 63) { BL[wid * 8 + j] = bcum; PL[wid * 8 + j] = p; }
    }
    __syncthreads();
    if (wid == 0) { float mcar = 0.f;
#pragma nounroll
        for (int c = 0; c < 64; ++c) { if (lane == 0) MC[c] = mcar; mcar = BL[c] + fmaxf(mcar, PL[c]); } }
    __syncthreads();
#pragma unroll
    for (int j = 0; j < 8; ++j) {
        const int c = wid * 8 + j; const size_t tok = (size_t)b * SEQL + c * 64 + lane;
        const float mcar = MC[c], mm = fmaxf(mcar, pm[j]), mrel = fmaxf(mcar, PL[c]);
        WIg[tok * 8 + h] = __expf(mcar - mm); EIg[tok * 8 + h] = __expf(-(bc[j] + mm)); Ag[tok * 8 + h] = av[j]; Rg[tok * 8 + h] = -mm; Ug[tok * 8 + h] = __expf(av[j] - mrel);
        if (lane == 0) DECg[(b * 8 + h) * 64 + c] = __expf(mcar - mrel);
    }
    __syncthreads();
}
__device__ __forceinline__ void mlstm_pre_unit(LAS unsigned char* lds_wg, int tid_in, int pair, bf16_t* z1, unsigned char* ws, bool st = true) {
    constexpr int QS = 272, SS = 144;
    constexpr int OFF_Q = 0, OFF_K = 64 * QS, OFF_KU = 2 * 64 * QS, OFF_SC = 3 * 64 * QS, OFF_VEC = OFF_SC + 64 * SS, UNIT_LDS = OFF_VEC + 512;
    int tid_ = tid_in; asm volatile("" : "+v"(tid_)); const int tid = tid_, lane = tid & 63, wid = __builtin_amdgcn_readfirstlane(tid >> 6), r = lane & 31, hh = lane >> 5;
    const int half = wid >> 2, w4 = wid & 3, t256 = tid & 255;
    const int ui = 2 * pair + half, b = ui >> 9, h = (ui >> 6) & 7, c = ui & 63;
    LAS unsigned char* lds = lds_wg + half * UNIT_LDS;
    LAS unsigned char* Qb = lds + OFF_Q; LAS unsigned char* Kb = lds + OFF_K; LAS unsigned char* KUb = lds + OFF_KU; LAS unsigned char* SCb = lds + OFF_SC;
    LAS float* A_ = (LAS float*)(lds + OFF_VEC); LAS float* R_ = A_ + 64;
    const size_t tok0 = (size_t)b * SEQL + c * 64; const int unit = (b * 8 + h) * 64 + c;
    const float* Ug = (const float*)(ws + GV_U);
    if (w4 == 0) { A_[lane] = ((const float*)(ws + GV_A))[(tok0 + lane) * 8 + h]; R_[lane] = ((const float*)(ws + GV_R))[(tok0 + lane) * 8 + h]; }
#pragma unroll
    for (int i = 0; i < 8; ++i) {
        const int row = (t256 >> 5) + 8 * i, cgi = t256 & 31, isk = cgi >> 4, c8 = (cgi & 15) * 8;
        bf16_t* gp = z1 + (tok0 + row) * Z1_LD + 1280 + isk * 1024 + h * 128 + c8;
        const u32x4 v = *(const u32x4*)gp;
        if (!isk) { *(LAS u32x4*)(Qb + row * QS + c8 * 2) = v; const float wis = ((const float*)(ws + GV_WI))[(tok0 + row) * 8 + h]; float f[8]; unpack8(v, f);
#pragma unroll
            for (int e = 0; e < 8; ++e) f[e] *= wis;
            if (st) *(u32x4*)gp = pack8(f); }
        else { *(LAS u32x4*)(Kb + row * QS + c8 * 2) = v; const float us = Ug[(tok0 + row) * 8 + h]; float f[8]; unpack8(v, f);
#pragma unroll
            for (int e = 0; e < 8; ++e) f[e] *= us;
            const u32x4 w = pack8(f); *(LAS u32x4*)(KUb + row * QS + c8 * 2) = w; if (st) *(u32x4*)gp = w; }
    }
    __syncthreads();
    if (w4 < 3) {
        const int tb = w4 >= 1, sb = w4 == 2;
        f32x16 sa;
#pragma unroll
        for (int i = 0; i < 16; ++i) sa[i] = 0.f;
#pragma unroll
        for (int ks = 0; ks < 8; ++ks) {
            const bf16x8 qa = *(const LAS bf16x8*)(Qb + (32 * tb + r) * QS + ks * 32 + hh * 16);
            const bf16x8 kb = *(const LAS bf16x8*)(Kb + (32 * sb + r) * QS + ks * 32 + hh * 16);
            sa = MFMA32(qa, kb, sa);
        }
        const int s = 32 * sb + r; const float as = A_[s];
#pragma unroll
        for (int i = 0; i < 16; ++i) {
            const int t = 32 * tb + (i & 3) + 8 * (i >> 2) + 4 * hh;
            const float w = (s <= t) ? __expf(as + R_[t]) : 0.f;
            *(LAS unsigned short*)(SCb + t * SS + s * 2) = (unsigned short)(pk2(sa[i] * w, 0.f) & 0xffffu);
            if (w4 == 0) *(LAS unsigned short*)(SCb + t * SS + (32 + r) * 2) = 0;
        }
    } else {
        float a0 = 0.f, a1 = 0.f;
#pragma unroll 8
        for (int s = 0; s < 64; ++s) { a0 += bf2f(*(const LAS unsigned short*)(KUb + s * QS + lane * 2)); a1 += bf2f(*(const LAS unsigned short*)(KUb + s * QS + (64 + lane) * 2)); }
        if (st) { ((float*)(ws + GV_DN))[(size_t)unit * 128 + lane] = a0; ((float*)(ws + GV_DN))[(size_t)unit * 128 + 64 + lane] = a1; } else asm volatile("" :: "v"(a0), "v"(a1));
    }
    __syncthreads();
#pragma unroll
    for (int j = 0; j < 2; ++j) { const int idx = t256 + 256 * j, row = idx >> 3, ch = idx & 7;
      const u32x4 o_ = *(const LAS u32x4*)(SCb + row * SS + ch * 16); if (st) *(u32x4*)((bf16_t*)(ws + WS_SC) + (size_t)unit * 4096 + row * 64 + ch * 8) = o_; else asm volatile("" :: "v"(o_)); }
    if (t256 < 64) { float d = 0.f;
#pragma unroll
        for (int k8 = 0; k8 < 8; ++k8) { float f[8]; unpack8(*(const LAS u32x4*)(SCb + t256 * SS + k8 * 16), f);
#pragma unroll
            for (int e = 0; e < 8; ++e) d += f[e]; }
        if (st) ((float*)(ws + GV_DI))[(tok0 + t256) * 8 + h] = d; else asm volatile("" :: "v"(d)); }
    __syncthreads();
}
__device__ __forceinline__ void mlstm_seq(LAS unsigned char* lds, int tid_in, int b, int h, const bf16_t* z1, const bf16_t* z2a, const float* g_hnorm, bf16_t* yb, const unsigned char* ws) {
    constexpr int QS = 272, US = 320, VS = 576, SS = 144;
    constexpr int OFF_Q = 0, OFF_KU = 64 * QS, OFF_V = OFF_KU + 64 * US, OFF_SC = OFF_V + 64 * VS, OFF_VEC = OFF_SC + 64 * SS;
    LAS unsigned char* Qb = lds + OFF_Q; LAS unsigned char* KUb = lds + OFF_KU; LAS unsigned char* Vb = lds + OFF_V; LAS unsigned char* SCb = lds + OFF_SC;
    LAS float* NV = (LAS float*)(lds + OFF_VEC); LAS float* INV = NV + 128; LAS float* PR = NV + 192; LAS float* GH = NV + 704;
    int tid_ = tid_in; asm volatile("" : "+v"(tid_)); const int tid = tid_, lane = tid & 63, wid = __builtin_amdgcn_readfirstlane(tid >> 6), r = lane & 31, hh = lane >> 5;
    const int g4 = lane >> 4, i16 = lane & 15, q4 = i16 >> 2, p4 = i16 & 3;
    const float* WIg = (const float*)(ws + GV_WI); const float* EIg = (const float*)(ws + GV_EI); const float* DIg = (const float*)(ws + GV_DI);
    const float* DECg = (const float*)(ws + GV_DEC) + (b * 8 + h) * 64; const float* DNg = (const float*)(ws + GV_DN) + (size_t)(b * 8 + h) * 64 * 128;
    const bf16_t* SCg = (const bf16_t*)(ws + WS_SC) + (size_t)(b * 8 + h) * 64 * 4096;
    f32x16 X[4];
#pragma unroll
    for (int d = 0; d < 4; ++d)
#pragma unroll
        for (int i = 0; i < 16; ++i) X[d][i] = 0.f;
    if (tid < 128) NV[tid] = 0.f;
    if (tid < 256) GH[tid] = g_hnorm[h * 256 + tid];
    u32x4 pq[2], pk[2], pv[4], psc; u32x2 pzo[2][4]; float pwi0, pwi1, pwq, peq, pdq, pdn = 0.f, pdec;
    const int srow = tid >> 4, sc16 = tid & 15;
    const int vrow = tid >> 5, vc = tid & 31;
    const int tq = tid >> 3, part = tid & 7;
#define ML_PREFETCH(cc) do { const size_t t0_ = (size_t)b * SEQL + (size_t)(cc) * 64; pdec = DECg[(cc)]; \
        _Pragma("unroll") for (int i = 0; i < 2; ++i) { const bf16_t* p_ = z1 + (t0_ + srow + 32 * i) * Z1_LD + 1280 + h * 128 + sc16 * 8; pq[i] = *(const u32x4*)p_; pk[i] = *(const u32x4*)(p_ + 1024); } \
        _Pragma("unroll") for (int i = 0; i < 4; ++i) pv[i] = *(const u32x4*)(z2a + (t0_ + vrow + 16 * i) * Z2_LD + h * 256 + vc * 8); \
        psc = *(const u32x4*)(SCg + (size_t)(cc) * 4096 + tid * 8); \
        _Pragma("unroll") for (int tb = 0; tb < 2; ++tb) _Pragma("unroll") for (int g = 0; g < 4; ++g) pzo[tb][g] = *(const u32x2*)(z2a + (t0_ + 32 * tb + r) * Z2_LD + 2048 + h * 256 + 32 * wid + 8 * g + 4 * hh); \
        pwi0 = WIg[(t0_ + r) * 8 + h]; pwi1 = WIg[(t0_ + 32 + r) * 8 + h]; pwq = WIg[(t0_ + tq) * 8 + h]; peq = EIg[(t0_ + tq) * 8 + h]; pdq = DIg[(t0_ + tq) * 8 + h]; \
        if (tid < 128) pdn = DNg[(size_t)(cc) * 128 + tid]; } while (0)
    ML_PREFETCH(0);
#pragma nounroll
    for (int c = 0; c < 64; ++c) {
        const size_t tok0 = (size_t)b * SEQL + c * 64;
        const float decay = pdec;
#pragma unroll
        for (int i = 0; i < 2; ++i) { *(LAS u32x4*)(Qb + (srow + 32 * i) * QS + sc16 * 16) = pq[i]; *(LAS u32x4*)(KUb + (srow + 32 * i) * US + sc16 * 16) = pk[i]; }
#pragma unroll
        for (int i = 0; i < 4; ++i) *(LAS u32x4*)(Vb + (vrow + 16 * i) * VS + vc * 16) = pv[i];
        *(LAS u32x4*)(SCb + (tid >> 3) * SS + (tid & 7) * 16) = psc;
        u32x2 zo[2][4];
#pragma unroll
        for (int tb = 0; tb < 2; ++tb)
#pragma unroll
            for (int g = 0; g < 4; ++g) zo[tb][g] = pzo[tb][g];
        const float wi0 = pwi0, wi1 = pwi1, wq = pwq, eq = peq, dq0 = pdq, dn = pdn;
        __syncthreads();
        if (c + 1 < 64) ML_PREFETCH(c + 1);
        f32x16 Z[2];
#pragma unroll
        for (int i = 0; i < 16; ++i) { Z[0][i] = 0.f; Z[1][i] = 0.f; }
#pragma unroll
        for (int dkb = 0; dkb < 4; ++dkb)
#pragma unroll
            for (int s2 = 0; s2 < 2; ++s2) {
                const bf16x8 ax = packacc8(X[dkb], 8 * s2);
#pragma unroll
                for (int tb = 0; tb < 2; ++tb) {
                    const LAS unsigned char* p = Qb + (32 * tb + r) * QS + (32 * dkb + 16 * s2 + 4 * hh) * 2;
                    const u32x2 lo = *(const LAS u32x2*)p, hi = *(const LAS u32x2*)(p + 16);
                    const u32x4 bq = {lo.x, lo.y, hi.x, hi.y};
                    Z[tb] = MFMA32(ax, __builtin_bit_cast(bf16x8, bq), Z[tb]);
                }
            }
        { float f[16]; { float t8[8]; unpack8(*(const LAS u32x4*)(Qb + tq * QS + part * 32), t8);
#pragma unroll
              for (int e = 0; e < 8; ++e) f[e] = t8[e];
              unpack8(*(const LAS u32x4*)(Qb + tq * QS + part * 32 + 16), t8);
#pragma unroll
              for (int e = 0; e < 8; ++e) f[8 + e] = t8[e]; }
          float dq = 0.f;
#pragma unroll
          for (int j = 0; j < 4; ++j) { const f32x4 n4 = *(const LAS f32x4*)(NV + 16 * part + 4 * j); dq += (f[4 * j] * n4[0] + f[4 * j + 1] * n4[1]) + (f[4 * j + 2] * n4[2] + f[4 * j + 3] * n4[3]); }
          dq += __shfl_xor(dq, 1); dq += __shfl_xor(dq, 2); dq += __shfl_xor(dq, 4);
          if (part == 0) INV[tq] = 1.f / fmaxf(fabsf(dq + dq0), eq); }
        bf16x8 vf[4];
#pragma unroll
        for (int ks = 0; ks < 4; ++ks) {
            const LAS unsigned char* p = Vb + (16 * ks + 8 * hh + q4) * VS + (32 * wid + 16 * (g4 & 1) + 4 * p4) * 2;
            vf[ks] = cat44(trread(p), trread(p + 4 * VS));
        }
#pragma unroll
        for (int tb = 0; tb < 2; ++tb)
#pragma unroll
            for (int ks = 0; ks < 4; ++ks) {
                const bf16x8 bs = *(const LAS bf16x8*)(SCb + (32 * tb + r) * SS + (16 * ks + 8 * hh) * 2);
                Z[tb] = MFMA32(vf[ks], bs, Z[tb]);
            }
        { float p0 = 0.f, p1 = 0.f;
#pragma unroll
          for (int i = 0; i < 16; ++i) { p0 += Z[0][i] * Z[0][i]; p1 += Z[1][i] * Z[1][i]; }
          p0 += __shfl_xor(p0, 32); p1 += __shfl_xor(p1, 32);
          if (hh == 0) { PR[r * 8 + wid] = p0; PR[(32 + r) * 8 + wid] = p1; } }
#pragma unroll
        for (int dkb = 0; dkb < 4; ++dkb) {
#pragma unroll
            for (int i = 0; i < 16; ++i) X[dkb][i] *= decay;
#pragma unroll
            for (int ks = 0; ks < 4; ++ks) {
                const LAS unsigned char* p = KUb + (16 * ks + 8 * hh + q4) * US + (32 * dkb + 16 * (g4 & 1) + 4 * p4) * 2;
                X[dkb] = MFMA32(cat44(trread(p), trread(p + 4 * US)), vf[ks], X[dkb]);
            }
        }
        LDS_WAIT(); __builtin_amdgcn_s_barrier(); asm volatile("" ::: "memory");
        if (tid < 128) NV[tid] = decay * NV[tid] + dn;
#pragma unroll
        for (int tb = 0; tb < 2; ++tb) {
            const int t = 32 * tb + r;
            const float inv = INV[t];
            const f32x4 pa = *(const LAS f32x4*)(PR + t * 8), pb = *(const LAS f32x4*)(PR + t * 8 + 4);
            const float rn = inv * rsqrtf(inv * inv * ((pa[0] + pa[1]) + (pa[2] + pa[3]) + (pb[0] + pb[1]) + (pb[2] + pb[3])) * (1.f / 256.f) + EPSN);
#pragma unroll
            for (int g = 0; g < 4; ++g) {
                const int dv = 32 * wid + 8 * g + 4 * hh;
                u32x2 w; w.x = pk2(Z[tb][4 * g] * rn * bflo(zo[tb][g].x), Z[tb][4 * g + 1] * rn * bfhi(zo[tb][g].x));
                w.y = pk2(Z[tb][4 * g + 2] * rn * bflo(zo[tb][g].y), Z[tb][4 * g + 3] * rn * bfhi(zo[tb][g].y));
                *(u32x2*)(yb + (tok0 + t) * Z2_LD + h * 256 + dv) = w;
            }
        }
    }
#undef ML_PREFETCH
}

__device__ __forceinline__ void qk_conv_item(int tid_in, int b, int strip, bf16_t* z1, const float* conv_qk) {
    int tid_ = tid_in; asm volatile("" : "+v"(tid_)); const int tid = tid_, lane = tid & 63, wid = __builtin_amdgcn_readfirstlane(tid >> 6), rl = lane >> 3, cg = lane & 7;
    const int ch = 64 * strip + 8 * cg;
    float w[4][8];
#pragma unroll
    for (int j = 0; j < 4; ++j) { const f32x4 a = *(const f32x4*)(conv_qk + j * 2048 + ch), c = *(const f32x4*)(conv_qk + j * 2048 + ch + 4);
#pragma unroll
        for (int e = 0; e < 4; ++e) { w[j][e] = a[e]; w[j][4 + e] = c[e]; } }
    const float qs = (ch < 1024) ? 0.08838834764831845f : 1.f;
    bf16_t* base = z1 + ((size_t)b * SEQL + 512 * wid) * Z1_LD + 1280 + ch;
    u32x4 prev = {0u, 0u, 0u, 0u};
    if (wid > 0) prev = *(const u32x4*)(base + (ptrdiff_t)(rl - 8) * Z1_LD);
    asm volatile("s_waitcnt vmcnt(0)" ::: "memory");
    __syncthreads();
    u32x4 cur4[4];
#pragma unroll
    for (int j = 0; j < 4; ++j) cur4[j] = *(const u32x4*)(base + (size_t)(8 * j + rl) * Z1_LD);
#pragma nounroll
    for (int blk = 0; blk < 16; ++blk) {
        u32x4 nxt4[4];
        if (blk + 1 < 16) {
#pragma unroll
            for (int j = 0; j < 4; ++j) nxt4[j] = *(const u32x4*)(base + (size_t)(32 * (blk + 1) + 8 * j + rl) * Z1_LD);
        }
#pragma unroll
        for (int j = 0; j < 4; ++j) {
            bf16_t* p = base + (size_t)(32 * blk + 8 * j + rl) * Z1_LD;
            const u32x4 cur = cur4[j];
            float x[8], y[8]; unpack8(cur, x);
#pragma unroll
            for (int e = 0; e < 8; ++e) y[e] = w[3][e] * x[e];
#pragma unroll
            for (int d = 1; d <= 3; ++d) {
                const u32x4 snd = (rl + d <= 7) ? cur : prev; const int src = (lane + 64 - 8 * d) & 63;
                u32x4 g; g.x = __shfl(snd.x, src); g.y = __shfl(snd.y, src); g.z = __shfl(snd.z, src); g.w = __shfl(snd.w, src);
                float xd[8]; unpack8(g, xd);
#pragma unroll
                for (int e = 0; e < 8; ++e) y[e] += w[3 - d][e] * xd[e];
            }
#pragma unroll
            for (int e = 0; e < 8; ++e) y[e] = y[e] * sigm(y[e]) * qs;
            *(u32x4*)p = pack8(y);
            prev = cur;
        }
#pragma unroll
        for (int j = 0; j < 4; ++j) cur4[j] = nxt4[j];
    }
}
__device__ __forceinline__ void ffn_conv_item(int tid_in, int b, int strip, bf16_t* h1, const bf16_t* h2, const float* cw, const float* cb, bool st = true) {
    int tid_ = tid_in; asm volatile("" : "+v"(tid_)); const int tid = tid_, lane = tid & 63, wid = __builtin_amdgcn_readfirstlane(tid >> 6), rl = lane >> 3, cg = lane & 7;
    const int ch = 64 * strip + 8 * cg;
    float wg[3][8], wv[3][8], bg[8], bv[8];
#pragma unroll
    for (int j = 0; j < 3; ++j) { const f32x4 a = *(const f32x4*)(cw + j * 11264 + ch), c = *(const f32x4*)(cw + j * 11264 + ch + 4), a2 = *(const f32x4*)(cw + j * 11264 + 5632 + ch), c2 = *(const f32x4*)(cw + j * 11264 + 5632 + ch + 4);
#pragma unroll
        for (int e = 0; e < 4; ++e) { wg[j][e] = a[e]; wg[j][4 + e] = c[e]; wv[j][e] = a2[e]; wv[j][4 + e] = c2[e]; } }
    { const f32x4 a = *(const f32x4*)(cb + ch), c = *(const f32x4*)(cb + ch + 4), a2 = *(const f32x4*)(cb + 5632 + ch), c2 = *(const f32x4*)(cb + 5632 + ch + 4);
#pragma unroll
      for (int e = 0; e < 4; ++e) { bg[e] = a[e]; bg[4 + e] = c[e]; bv[e] = a2[e]; bv[4 + e] = c2[e]; } }
    const size_t off0 = ((size_t)b * SEQL + 512 * wid) * 5632 + ch;
    u32x4 pg = {0u, 0u, 0u, 0u}, pv = {0u, 0u, 0u, 0u};
    if (wid > 0) { pg = *(const u32x4*)(h1 + off0 + (ptrdiff_t)(rl - 8) * 5632); pv = *(const u32x4*)(h2 + off0 + (ptrdiff_t)(rl - 8) * 5632); }
    asm volatile("s_waitcnt vmcnt(0)" ::: "memory");
    __syncthreads();
    u32x4 cg4[4], cv4[4];
#pragma unroll
    for (int j = 0; j < 4; ++j) { cg4[j] = __builtin_nontemporal_load((const u32x4*)(h1 + off0 + (size_t)(8 * j + rl) * 5632)); cv4[j] = __builtin_nontemporal_load((const u32x4*)(h2 + off0 + (size_t)(8 * j + rl) * 5632)); }
#pragma nounroll
    for (int blk = 0; blk < 16; ++blk) {
        u32x4 ng4[4], nv4[4];
        if (blk + 1 < 16) {
#pragma unroll
            for (int j = 0; j < 4; ++j) { const size_t o_ = off0 + (size_t)(32 * (blk + 1) + 8 * j + rl) * 5632; ng4[j] = __builtin_nontemporal_load((const u32x4*)(h1 + o_)); nv4[j] = __builtin_nontemporal_load((const u32x4*)(h2 + o_)); }
        }
#pragma unroll
        for (int j = 0; j < 4; ++j) {
            const size_t off = off0 + (size_t)(32 * blk + 8 * j + rl) * 5632;
            const u32x4 cgv = cg4[j], cvv = cv4[j];
            float xg[8], xv[8], yg[8], yv[8]; unpack8(cgv, xg); unpack8(cvv, xv);
#pragma unroll
            for (int e = 0; e < 8; ++e) { yg[e] = bg[e] + wg[2][e] * xg[e]; yv[e] = bv[e] + wv[2][e] * xv[e]; }
#pragma unroll
            for (int d = 1; d <= 2; ++d) {
                const bool own = (rl + d <= 7); const int src = (lane + 64 - 8 * d) & 63;
                const u32x4 sg = own ? cgv : pg, sv = own ? cvv : pv;
                u32x4 g, v; g.x = __shfl(sg.x, src); g.y = __shfl(sg.y, src); g.z = __shfl(sg.z, src); g.w = __shfl(sg.w, src);
                v.x = __shfl(sv.x, src); v.y = __shfl(sv.y, src); v.z = __shfl(sv.z, src); v.w = __shfl(sv.w, src);
                float dg[8], dv[8]; unpack8(g, dg); unpack8(v, dv);
#pragma unroll
                for (int e = 0; e < 8; ++e) { yg[e] += wg[2 - d][e] * dg[e]; yv[e] += wv[2 - d][e] * dv[e]; }
            }
#pragma unroll
            for (int e = 0; e < 8; ++e) yg[e] = yg[e] * sigm(yg[e]) * yv[e];
            { const u32x4 o_ = pack8(yg); if (st) *(u32x4*)(h1 + off) = o_; else asm volatile("" :: "v"(o_)); }
            pg = cgv; pv = cvv;
        }
#pragma unroll
        for (int j = 0; j < 4; ++j) { cg4[j] = ng4[j]; cv4[j] = nv4[j]; }
    }
}
__device__ __forceinline__ void tr_item(const float* W, int N, int scol0, int valid, const float* gain, bf16_t* WT, int K, int drow0, LAS float* scr, int kb, int lane) {
    const int k0 = 64 * kb, rr = lane >> 3, c4 = (lane & 7) * 4;
    f32x4 tv[8];
#pragma unroll
    for (int i = 0; i < 8; ++i) tv[i] = (c4 < valid) ? __builtin_nontemporal_load((const f32x4*)(W + (size_t)(k0 + 8 * i + rr) * N + scol0 + c4)) : (f32x4){0.f, 0.f, 0.f, 0.f};
#pragma unroll
    for (int i = 0; i < 8; ++i) { const int kk = 8 * i + rr; const float g = gain ? gain[k0 + kk] : 1.f;
        scr[kk * 33 + c4] = tv[i][0] * g; scr[kk * 33 + c4 + 1] = tv[i][1] * g; scr[kk * 33 + c4 + 2] = tv[i][2] * g; scr[kk * 33 + c4 + 3] = tv[i][3] * g; }
    LDS_WAIT(); asm volatile("" ::: "memory");
    const int c = lane & 7;
#pragma unroll
    for (int j = 0; j < 4; ++j) { const int nn = (lane >> 3) + 8 * j; const LAS float* s = scr + (8 * c) * 33 + nn;
        u32x4 o; o.x = pk2(s[0 * 33], s[1 * 33]); o.y = pk2(s[2 * 33], s[3 * 33]); o.z = pk2(s[4 * 33], s[5 * 33]); o.w = pk2(s[6 * 33], s[7 * 33]);
        *(u32x4*)(WT + (size_t)(drow0 + nn) * K + k0 + 8 * c) = o; }
    LDS_WAIT(); asm volatile("" ::: "memory");
}
__device__ const float INVF[32] = {1.000000000e+00f, 7.498942018e-01f, 5.623413324e-01f, 4.216965139e-01f, 3.162277639e-01f, 2.371373773e-01f, 1.778279394e-01f, 1.333521456e-01f, 1.000000015e-01f, 7.498942316e-02f, 5.623413250e-02f, 4.216964915e-02f, 3.162277490e-02f, 2.371373773e-02f, 1.778279431e-02f, 1.333521400e-02f, 9.999999776e-03f, 7.498942316e-03f, 5.623413250e-03f, 4.216964822e-03f, 3.162277630e-03f, 2.371373819e-03f, 1.778279431e-03f, 1.333521446e-03f, 1.000000047e-03f, 7.498941850e-04f, 5.623413017e-04f, 4.216965172e-04f, 3.162277571e-04f, 2.371373703e-04f, 1.778279402e-04f, 1.333521504e-04f};
__device__ __forceinline__ void tr_mat_item(ArgsP a, int mat, int item, LAS float* scr, int lane) {
    const float* src; const float* gain = nullptr; int K, N, nblk; size_t dst;
    int nb0 = 0;
    switch (mat) {
        case 0: src = a->in[4]; K = 2048; N = 11344; nblk = 360; dst = WS_WIN_T; break;
        case 12: src = a->in[4]; K = 2048; N = 11344; nblk = 104; dst = WS_WIN_T; mat = 0; break;
        case 13: src = a->in[4]; K = 2048; N = 11344; nblk = 256; nb0 = 104; dst = WS_WIN_T; mat = 0; break;
        case 1: src = a->in[6]; K = 512; N = 3072; nblk = 96; dst = WS_WQB_T; gain = a->in[5]; break;
        case 2: src = a->in[8]; K = 512; N = 4096; nblk = 128; dst = WS_WKVB_T; gain = a->in[7]; break;
        case 3: src = a->in[16]; K = 2048; N = 2048; nblk = 64; dst = WS_PA_T; break;
        case 4: src = a->in[17]; K = 2048; N = 2048; nblk = 64; dst = WS_PB_T; break;
        case 5: src = a->in[18]; K = 2048; N = 2048; nblk = 64; dst = WS_WOUT_T; break;
        case 6: src = a->in[21]; K = 2048; N = 512; nblk = 16; dst = WS_WQC_T; gain = a->in[19]; break;
        case 7: src = a->in[22]; K = 2048; N = 512; nblk = 16; dst = WS_WKC_T; break;
        case 8: src = a->in[23]; K = 2048; N = 512; nblk = 16; dst = WS_WVC_T; break;
        case 9: src = a->in[26]; K = 512; N = 2048; nblk = 64; dst = WS_WOC_T; break;
        case 10: src = a->in[28]; K = 2048; N = 11264; nblk = 352; dst = WS_WUP_T; gain = a->in[27]; break;
        default: src = a->in[31]; K = 5632; N = 2048; nblk = 64; dst = WS_WDN_T; break;
    }
    const int kb = item / nblk, nb = item % nblk + nb0;
    int scol = 32 * nb, drow = 32 * nb, valid = 32;
    if (mat == 0) {
        if (drow < 1088) scol = drow; else if (drow == 1088) { scol = 5184; valid = 16; } else if (drow < 1280) { scol = 0; valid = 0; } else if (drow < 5376) scol = drow - 192; else scol = drow - 176;
    } else if (mat == 1) {
        const int hq = scol / 192, w = scol % 192;
        if (w < 128) drow = 128 * hq + w; else drow = 2048 + 256 * (hq >> 2) + 128 * ((w - 128) >> 5) + 32 * (hq & 3);
    } else if (mat == 2) {
        const int hk = scol / 256, w = scol % 256;
        drow = (w < 128) ? 128 * hk + w : 2048 + 128 * hk + (w - 128);
    }
    if (mat == 0 && drow >= 7424) { dst = WS_WING; drow -= 7424; }
    tr_item(src, N, scol, valid, gain, (bf16_t*)(a->ws + dst), K, drow, scr, kb, lane);
}
__device__ __forceinline__ void norm_row(const float* xr, const float* g, bf16_t* orow, int lane) {
    f32x4 v[8]; float s = 0.f;
#pragma unroll
    for (int j = 0; j < 8; ++j) { v[j] = __builtin_nontemporal_load((const f32x4*)(xr + 4 * lane + 256 * j)); s += (v[j][0] * v[j][0] + v[j][1] * v[j][1]) + (v[j][2] * v[j][2] + v[j][3] * v[j][3]); }
    const float rs = rsqrtf(wave_sum(s) * (1.f / 2048.f) + EPSN);
#pragma unroll
    for (int j = 0; j < 8; ++j) { const f32x4 gg = *(const f32x4*)(g + 4 * lane + 256 * j); u32x2 w; w.x = pk2(v[j][0] * rs * gg[0], v[j][1] * rs * gg[1]); w.y = pk2(v[j][2] * rs * gg[2], v[j][3] * rs * gg[3]);
        *(u32x2*)(orow + 4 * lane + 256 * j) = w; }
}

__global__ void __launch_bounds__(512, 2) mk_fwd(Args a_) {
    extern __shared__ __attribute__((aligned(16))) unsigned char lds_raw[];
    LAS unsigned char* lds = (LAS unsigned char*)lds_raw;
    cg::grid_group grid = cg::this_grid();
    const int ph_lo = a_.ph_lo, ph_hi = a_.ph_hi;
    if (threadIdx.x < 2) ((volatile LAS unsigned*)(lds + LDS_MISC))[threadIdx.x] = 0u;
    __syncthreads();
    const XcdBarrier xbar = xcd_barrier_post((unsigned*)(a_.ws + WS_BAR), (volatile LAS unsigned*)(lds + LDS_MISC));
    const int wid0 = __builtin_amdgcn_readfirstlane((int)threadIdx.x >> 6);
    for (int ph = ph_lo; ph < ph_hi; ++ph) {
        ArgsP a = (ArgsP)__builtin_amdgcn_kernarg_segment_ptr(); asm volatile("" : "+s"(a));
        int bid_ = blockIdx.x; asm volatile("" : "+s"(bid_));
        const int G = gridDim.x, bid = bid_;
#define MK_TID() ({ int w_ = wid0, z_ = 0; asm volatile("" : "+s"(w_), "+s"(z_)); w_ * 64 + (int)__builtin_amdgcn_mbcnt_hi(~0u, __builtin_amdgcn_mbcnt_lo(~0u, (unsigned)z_)); })
        unsigned char* ws = a->ws; unsigned char* ob = (unsigned char*)a->out;
        float* ssq_qa = (float*)(ws + WS_SSQ_QA); float* ssq_kv = (float*)(ws + WS_SSQ_KV); float* ssq_x1 = (float*)(ws + WS_SSQ_X1); float* ssq_x2 = (float*)(ws + WS_SSQ_X2);
        float* ropec = (float*)(ws + WS_ROPE); float* ropes = ropec + (size_t)MT * 32;
        bf16_t* z1 = (bf16_t*)(ws + WS_Z1); bf16_t* ub = (bf16_t*)(ws + WS_U); bf16_t* z2a = (bf16_t*)(ws + WS_Z2A); bf16_t* z2b = (bf16_t*)(ob + O_Z2B);
        bf16_t* qn = (bf16_t*)(ob + O_QN); bf16_t* qpe = (bf16_t*)(ob + O_QPE); bf16_t* kn = (bf16_t*)(ws + WS_KN); bf16_t* vb = (bf16_t*)(ws + WS_V); bf16_t* kpe = (bf16_t*)(ws + WS_KPE);
        bf16_t* ya = (bf16_t*)(ws + WS_YA); bf16_t* ta = (bf16_t*)(ws + WS_TA); bf16_t* x1b = (bf16_t*)(ws + WS_X1B); bf16_t* x2b = (bf16_t*)(ws + WS_X2B);
        bf16_t* memn = (bf16_t*)(ws + WS_MEMN); bf16_t* qc = (bf16_t*)(ws + WS_QC); bf16_t* kc = (bf16_t*)(ws + WS_KC); bf16_t* vc = (bf16_t*)(ws + WS_VC); bf16_t* oc = (bf16_t*)(ws + WS_OC);
        bf16_t* h1 = (bf16_t*)(ws + WS_H1); bf16_t* h2 = (bf16_t*)(ws + WS_H2);


#ifndef MK_DUP
#define MK_DUP (-1)
#endif
#ifndef MK_DUPS
#define MK_DUPS (-1)
#endif
        for (int rep = 0; rep < (((MK_DUP >= 0 && ph == MK_DUP) || (MK_DUPS >= 0 && ph == MK_DUPS)) ? 2 : 1); ++rep) {
        if (ph == 0) {
            const int tid = MK_TID(), lane = tid & 63, wid = __builtin_amdgcn_readfirstlane(tid >> 6), gw = bid * 8 + wid, NGW = G * 8;
            for (int i = bid * 512 + tid; i < 4 * MT;) { ((float*)(ws + WS_SSQ_QA))[i] = 0.f; i += G * 512; asm volatile("" : "+v"(i)); }
            const int* pos = (const int*)a->in[2];
            for (int i = bid * 512 + tid; i < MT * 32;) {
                const float ang = (float)pos[i >> 5] * INVF[i & 31];
                double rd = (double)ang; rd -= rint(rd * 0.15915494309189535) * 6.283185307179586;
                const float rf = (float)rd; ropec[i] = __cosf(rf); ropes[i] = __sinf(rf);
                i += G * 512; asm volatile("" : "+v"(i));
            }
            LAS float* scr = (LAS float*)(lds + wid * 16384);
#pragma nounroll
            for (int it = gw; it < 3328 + 1792; it += NGW) {
                if (it < 3328) tr_mat_item(a, 12, it, scr, lane); else if (it < 3328 + 768) tr_mat_item(a, 1, it - 3328, scr, lane); else tr_mat_item(a, 2, it - 4096, scr, lane);
            }
#pragma unroll 2
            for (int m = gw; m < MT; m += NGW) norm_row(a->in[0] + (size_t)m * 2048, a->in[3], ub + (size_t)m * 2048, lane);
#pragma nounroll
            for (int m = gw; m < 1024; m += NGW) norm_row(a->in[1] + (size_t)m * 2048, a->in[20], memn + (size_t)m * 2048, lane);
        } else if (ph == 3) {
            const int tid = MK_TID(), wid = __builtin_amdgcn_readfirstlane(tid >> 6);
            for (int ui = bid; ui < 1024 && !(MK_DUPS == 3 && rep == 1); ui += G) {
                const int rnd = ui >> 8, c0 = ui & 255, xcd = c0 & 7, w = c0 >> 3;
                const int bh = 8 * xcd + 2 * rnd + (w >> 4), b = bh >> 4, h = bh & 15, qb = (rnd & 1) ? 15 - (w & 15) : (w & 15);
                const size_t row0 = (size_t)b * SEQL + qb * 256, kr0 = (size_t)b * SEQL;
                attn_unit<12>(lds, tid, qn + row0 * 2048 + h * 128, 2048, qpe + row0 * 1024 + h * 64, 1024, kn + kr0 * 2048 + h * 128, 2048, kpe + kr0 * 64, 64,
                              vb + kr0 * 2048 + h * 128, 2048, ya + row0 * 2048 + h * 128, 2048, 4 * qb + 4, 4 * qb + (wid >> 1) + 1, 0.07216878364870322f * 1.4426950408889634f);
            }
            for (int ui = bid; ui < 1024; ui += G) mlstm_pre_unit(lds, tid, ui, z1, ws, MK_DUPS != 3 || rep == 1);
            if (MK_DUPS == 3 && rep == 0) continue;
        } else if (ph == 5) {
            const int tid = MK_TID();
            if (rep > 0) {} else if (G > 2 * NML) { if (bid < NML) mlstm_seq(lds, tid, bid >> 3, bid & 7, z1, z2a, a->in[15], z2a, ws); }
            else for (int ui = bid; ui < 32; ui += G) mlstm_seq(lds, tid, ui >> 3, ui & 7, z1, z2a, a->in[15], z2a, ws);
        } else if (ph == 9) {
            const int tid = MK_TID();
            for (int ui = bid; ui < 256; ui += G) {
                const int b = ui >> 6, hc = (ui >> 4) & 3, qb = ui & 15;
                const size_t row0 = (size_t)b * SEQL + qb * 256, kr0 = (size_t)b * 256;
                attn_unit<8, true>(lds, tid, qc + row0 * 512 + hc * 128, 512, nullptr, 0, kc + kr0 * 512 + hc * 128, 512, nullptr, 0, vc + kr0 * 512 + hc * 128, 512, oc + row0 * 512 + hc * 128, 512, 4, 4,
                             0.08838834764831845f * 1.4426950408889634f);
            }
        } else if (ph == 12) {
            const int tid = MK_TID();
            for (int ui = bid; ui < 4 * 88; ui += G) { ffn_conv_item(tid, ui / 88, ui % 88, h1, h2, a->in[29], a->in[30], MK_DUPS != 12 || rep == 1); __syncthreads(); }
        }
        const int nbf = (ph == 1 || ph == 4 || ph == 5 || ph == 11) ? 1 : (ph == 2 || ph == 6) ? 2 : (ph == 8) ? 3 : 0;
        for (int gi = 0; gi < nbf; ++gi) {
            pg8::Gemm g; g.M = MT; g.K = 2048; g.lda = 2048; g.N = 2048; g.A = ub; g.Bt = nullptr;
            EpiBF E; E.mode = EM_Z1; E.a0 = a; E.P = (LAS float*)(lds + LDS_EPI);
            int cshift = 0;
            if (ph == 1) { g.Bt = (const bf16_t*)(ws + WS_WIN_T); g.N = 3328; E.mode = EM_Z1; }
            else if (ph == 2 && gi == 0) { g.A = z1; g.lda = Z1_LD; g.K = 512; g.Bt = (const bf16_t*)(ws + WS_WQB_T); g.N = 3072; E.mode = EM_Q; }
            else if (ph == 2) { g.A = z1 + 512; g.lda = Z1_LD; g.K = 512; g.Bt = (const bf16_t*)(ws + WS_WKVB_T); g.N = 4096; E.mode = EM_KV; }
            else if (ph == 4) { g.Bt = (const bf16_t*)(ws + WS_WIN_T) + (size_t)3328 * 2048; g.N = 4096; E.mode = EM_Z2; }
            else if (ph == 5) { g.Bt = (const bf16_t*)(ws + WS_WING); g.N = 4096; E.mode = EM_ZG; }
            else if (ph == 6 && gi == 0) { g.A = ya; g.Bt = (const bf16_t*)(ws + WS_PA_T); E.mode = EM_GA; }
            else if (ph == 6) { g.A = z2a; g.lda = Z2_LD; g.Bt = (const bf16_t*)(ws + WS_PB_T); E.mode = EM_GB; }
            else if (ph == 8 && gi == 0) { g.A = x1b; g.Bt = (const bf16_t*)(ws + WS_WQC_T); g.N = 512; E.mode = EM_QC; }
            else if (ph == 8 && gi == 1) { g.A = memn; g.M = 1024; g.Bt = (const bf16_t*)(ws + WS_WKC_T); g.N = 512; E.mode = EM_KC; cshift = 128; }
            else if (ph == 8) { g.A = memn; g.M = 1024; g.Bt = (const bf16_t*)(ws + WS_WVC_T); g.N = 512; E.mode = EM_VC; cshift = 136; }
            else { g.A = x2b; g.Bt = (const bf16_t*)(ws + WS_WUP_T); g.N = 11264; E.mode = EM_UP; }
            int cc_ = bid - cshift, Gg = G; if (cc_ < 0) cc_ += G; if (cc_ < 0) cc_ = bid;
            if (ph == 5 && G > 2 * NML) { if (bid < NML) continue; Gg = G - NML; cc_ = bid - NML; }
            pg8::StaticOrder S; S.init(g.M, g.N, Gg, cc_);
            pg8::gemm_phase<EpiBF, pg8::StaticOrder, true, true>(lds, MK_TID(), g, S, E);
        }
        }
        if (ph == 7 || ph == 10 || ph == 13) {
            pg8::Gemm g; g.M = MT; g.N = 2048; EpiF32 E; E.a0 = a;
            if (ph == 7) { g.A = ta; g.lda = 2048; g.K = 2048; g.Bt = (const bf16_t*)(ws + WS_WOUT_T); E.mode = 0; }
            else if (ph == 10) { g.A = oc; g.lda = 512; g.K = 512; g.Bt = (const bf16_t*)(ws + WS_WOC_T); E.mode = 1; }
            else { g.A = h1; g.lda = 5632; g.K = 5632; g.Bt = (const bf16_t*)(ws + WS_WDN_T); E.mode = 2; }
            pg8::StaticOrder S; S.init(g.M, g.N, G, bid);
            pg8::gemm_phase<EpiF32, pg8::StaticOrder, true, true>(lds, MK_TID(), g, S, E);
        }
        if (ph == 1) {
            const int tid = MK_TID(), lane = tid & 63, wid = __builtin_amdgcn_readfirstlane(tid >> 6);
            LAS float* scr = (LAS float*)(lds + wid * 16384);
            const int first = (G >= 128) ? 64 : 0, nw = (G - first) * 8;
            if (bid >= first) {
#pragma nounroll
                for (int it = (bid - first) * 8 + wid; it < 8192; it += nw) {
                    int r = it, mat;
                    if (r < 2048) mat = 3; else if ((r -= 2048) < 2048) mat = 4; else if ((r -= 2048) < 2048) mat = 5; else if ((r -= 2048) < 512) mat = 6; else if ((r -= 512) < 512) mat = 7; else if ((r -= 512) < 512) mat = 8; else { r -= 512; mat = 9; }
                    tr_mat_item(a, mat, r, scr, lane);
                }
            }
        } else if (ph == 2) {
            const int tid = MK_TID(), lane = tid & 63, wid = __builtin_amdgcn_readfirstlane(tid >> 6), gw = bid * 8 + wid, NGW = G * 8;
            const float* gk = a->in[12];
#pragma unroll 4
            for (int m = gw; m < MT; m += NGW) {
                const int l = lane & 31;
                const float x1 = bf2f(z1[(size_t)m * Z1_LD + 1024 + l]), x2 = bf2f(z1[(size_t)m * Z1_LD + 1056 + l]);
                const float s = wave_sum(lane < 32 ? x1 * x1 + x2 * x2 : 0.f);
                const float rn = rsqrtf(s * (1.f / 64.f) + EPSN);
                const float a1 = x1 * rn * gk[l], a2 = x2 * rn * gk[32 + l], cc = ropec[(size_t)m * 32 + l], ss = ropes[(size_t)m * 32 + l];
                if (lane < 32) { kpe[(size_t)m * 64 + l] = (bf16_t)(pk2(a1 * cc - a2 * ss, 0.f) & 0xffffu); kpe[(size_t)m * 64 + 32 + l] = (bf16_t)(pk2(a2 * cc + a1 * ss, 0.f) & 0xffffu); }
            }
            if (G >= 160) { if (bid >= 128 && bid < 160) gate_scan(lds, tid, (bid - 128) >> 3, bid & 7, z1, a->in[14], ws); }
            else for (int ui = bid; ui < 32; ui += G) gate_scan(lds, tid, ui >> 3, ui & 7, z1, a->in[14], ws);
            for (int ui = bid; ui < 4 * 32; ui += G) { qk_conv_item(tid, ui >> 5, ui & 31, z1, a->in[13]); __syncthreads(); }
            if (G >= 200) { if (bid >= 132) {
                LAS float* scr = (LAS float*)(lds + wid * 16384);
#pragma nounroll
                for (int it = (bid - 132) * 8 + wid; it < 8192; it += (G - 132) * 8) tr_mat_item(a, 13, it, scr, lane); } }
            else { LAS float* scr = (LAS float*)(lds + wid * 16384);
#pragma nounroll
                for (int it = gw; it < 8192; it += NGW) tr_mat_item(a, 13, it, scr, lane); }
        } else if (ph == 8) {
            const int tid = MK_TID(), lane = tid & 63, wid = __builtin_amdgcn_readfirstlane(tid >> 6), gw = bid * 8 + wid, NGW = G * 8;
            LAS float* scr = (LAS float*)(lds + wid * 16384);
#pragma nounroll
            for (int it = gw; it < 5632; it += NGW) tr_mat_item(a, 11, it, scr, lane);
        } else if (ph == 5) {
            const int tid = MK_TID(), lane = tid & 63, wid = __builtin_amdgcn_readfirstlane(tid >> 6);
            LAS float* scr = (LAS float*)(lds + wid * 16384);
            if (G > 2 * NML) { if (bid >= NML) {
#pragma nounroll
                for (int it = (bid - NML) * 8 + wid; it < 11264; it += (G - NML) * 8) tr_mat_item(a, 10, it, scr, lane); } }
            else {
#pragma nounroll
                for (int it = bid * 8 + wid; it < 11264; it += G * 8) tr_mat_item(a, 10, it, scr, lane); }
        }
        if (ph + 1 < ph_hi) { if (ph >= 1000) grid.sync(); else xcd_barrier(xbar); }
    }
}

extern "C" void kernel_launch(void* const* d_in, const int* in_sizes, int n_in, void* d_out, int out_size, void* d_ws, size_t ws_size, hipStream_t stream) {
    static int grid = 0;
    if (grid == 0) {
        if (n_in != 32 || in_sizes[0] != MT * 2048 || out_size != MT * 2048 || ws_size < WS_NEED) { fprintf(stderr, "kernel_launch: unexpected shapes / workspace (n_in %d, ws %zu)\n", n_in, ws_size); grid = -1; return; }
        int dev = 0, cus = 0, per_cu = 0;
        (void)hipGetDevice(&dev); (void)hipDeviceGetAttribute(&cus, hipDeviceAttributeMultiprocessorCount, dev);
        if (hipFuncSetAttribute((const void*)mk_fwd, hipFuncAttributeMaxDynamicSharedMemorySize, LDS_BYTES) != hipSuccess) { fprintf(stderr, "kernel_launch: hipFuncSetAttribute failed\n"); grid = -1; return; }
        if (hipOccupancyMaxActiveBlocksPerMultiprocessor(&per_cu, (const void*)mk_fwd, 512, LDS_BYTES) != hipSuccess || per_cu < 1) { fprintf(stderr, "kernel_launch: occupancy query says %d blocks per CU\n", per_cu); per_cu = 1; }
        (void)hipGetLastError();
        grid = cus > 0 ? cus : 256;
    }
    if (grid < 0) return;
    if (hipMemsetAsync((char*)d_ws + WS_BAR, 0, BAR_BYTES, stream) != hipSuccess) { fprintf(stderr, "kernel_launch: memset of the barrier words failed\n"); return; }
    Args a{};
    for (int i = 0; i < 32; ++i) a.in[i] = (const float*)d_in[i];
    a.out = (float*)d_out; a.ws = (unsigned char*)d_ws;
#ifndef MK_MULTI
    a.ph_lo = 0; a.ph_hi = NPHASE;
    void* args[] = {&a};
    hipError_t e = hipLaunchCooperativeKernel((const void*)mk_fwd, dim3(grid), dim3(512), args, LDS_BYTES, stream);
    if (e != hipSuccess) fprintf(stderr, "kernel_launch: cooperative launch failed: %s (grid %d)\n", hipGetErrorString(e), grid);
#else
    for (int p = 0; p < NPHASE; ++p) { a.ph_lo = p; a.ph_hi = p + 1; hipLaunchKernelGGL(mk_fwd, dim3(grid), dim3(512), LDS_BYTES, stream, a); }
#endif
}
```
